# Optimizing an MI355X kernel written in HIP

```python
import math
import jax, jax.numpy as jnp
from jax import lax
import numpy as np

D_MODEL = 1024
BATCH = 8
SEQ = 4096
DEPTH = 2
DEC_BATCH = 16
DEC_SEQ = 64
PAST_LEN = 4096

CHUNK = 64
N_EVEN = (DEPTH + 1) // 2
N_ODD = DEPTH // 2
EPS = 1e-6
D_FF = 2816
POOL_WINDOWS = (2, 4, 8, 16)
POOL_GROUPS = 4
POOL_GW = 96
POOL_W = POOL_GROUPS * POOL_GW
POOL_PAD = max(POOL_WINDOWS) - 1
HEAD_DIM = 64
SWA_KV_HEADS = 2
SWA_GROUP = 8
SWA_HEADS = SWA_KV_HEADS * SWA_GROUP
SWA_Q_W = SWA_HEADS * HEAD_DIM
SWA_KV_W = SWA_KV_HEADS * HEAD_DIM
WINDOW = 128
WIN_CHUNKS = WINDOW // CHUNK
EVEN_IN = POOL_W + SWA_Q_W + 2 * SWA_KV_W
EVEN_MIX = POOL_W + SWA_Q_W
DIFF_HEADS = 8
DIFF_DH = 2 * HEAD_DIM
DIFF_W = DIFF_HEADS * DIFF_DH
QBLK = 128
GMLP_GROUPS = 4
GMLP_GW = 96
GMLP_W = GMLP_GROUPS * GMLP_GW
GMLP_CHUNK = 128
ODD_IN = 3 * DIFF_W + 2 * GMLP_W
ODD_MIX = DIFF_W + GMLP_W

kernel_name = 'hybrid_pool_swa_diff_gmlp_stream_step'


def rmsnorm(x, g):
    xf = x.astype(jnp.float32)
    y = xf * lax.rsqrt(jnp.mean(xf * xf, axis=-1, keepdims=True) + EPS)
    return (y * g.astype(jnp.float32)).astype(x.dtype)


def layernorm(x, g, b):
    xf = x.astype(jnp.float32)
    mu = jnp.mean(xf, axis=-1, keepdims=True)
    var = jnp.mean(jnp.square(xf - mu), axis=-1, keepdims=True)
    y = (xf - mu) * lax.rsqrt(var + EPS) * g.astype(jnp.float32) + b.astype(jnp.float32)
    return y.astype(x.dtype)


def swiglu(h, wg, wu, wd):
    return (jax.nn.silu(h @ wg) * (h @ wu)) @ wd


def pool_mixer(u, prev, pos0, w_grp, scale):
    b, L, _ = u.shape
    p = jnp.concatenate([prev, u], axis=1)
    pf = p.astype(jnp.float32)
    cs = jnp.concatenate([jnp.zeros((b, 1, POOL_W), jnp.float32), jnp.cumsum(pf, axis=1)], axis=1)
    uf = pf[:, POOL_PAD:]
    pos = pos0 + jnp.arange(L)
    diffs = []
    for g, w in enumerate(POOL_WINDOWS):
        sl = slice(g * POOL_GW, (g + 1) * POOL_GW)
        s = cs[:, POOL_PAD + 1:POOL_PAD + 1 + L, sl] - cs[:, POOL_PAD + 1 - w:POOL_PAD + 1 - w + L, sl]
        cnt = jnp.minimum(pos + 1, w).astype(jnp.float32)
        diffs.append(s / cnt[None, :, None] - uf[..., sl])
    d = jnp.stack(diffs, axis=2)
    y = jnp.einsum('blgc,gcd->blgd', d, w_grp.astype(jnp.float32)).reshape(b, L, POOL_W)
    y = y * scale.astype(jnp.float32)
    return y.astype(u.dtype), p[:, -POOL_PAD:]


def band_keys(t, nc):
    b = t.shape[0]
    tp = jnp.pad(t, ((0, 0), (WINDOW, 0), (0, 0), (0, 0))).reshape(b, nc + WIN_CHUNKS, CHUNK, SWA_KV_HEADS, HEAD_DIM)
    return jnp.concatenate([tp[:, i:i + nc] for i in range(WIN_CHUNKS + 1)], axis=2)


def swa_core(q, k, v, key_ok, sink):
    s = jnp.einsum('bnqhgd,bnkhd->bnhgqk', q, k).astype(jnp.float32) * (HEAD_DIM ** -0.5)
    s = jnp.where(key_ok[None, :, None, None, None, :], s, -jnp.inf)
    sk = jnp.broadcast_to(sink.astype(jnp.float32)[None, None, :, :, None, None], s.shape[:-1] + (1,))
    p = jax.nn.softmax(jnp.concatenate([s, sk], axis=-1), axis=-1)[..., :-1]
    return jnp.einsum('bnhgqk,bnkhd->bnqhgd', p.astype(v.dtype), v)


def even_mixer(h, w_in, w_out, pool_w, pool_scale, sink, cache_pool, cache_k, cache_v):
    b, L, _ = h.shape
    u, q, k, v = jnp.split(h @ w_in, [POOL_W, POOL_W + SWA_Q_W, POOL_W + SWA_Q_W + SWA_KV_W], axis=-1)
    q = q.reshape(b, L, SWA_KV_HEADS, SWA_GROUP, HEAD_DIM)
    k = k.reshape(b, L, SWA_KV_HEADS, HEAD_DIM)
    v = v.reshape(b, L, SWA_KV_HEADS, HEAD_DIM)
    if cache_k is None:
        prev = jnp.zeros((b, POOL_PAD, POOL_W), u.dtype)
        pos0 = 0
        nc = L // CHUNK
        qb = q.reshape(b, nc, CHUNK, SWA_KV_HEADS, SWA_GROUP, HEAD_DIM)
        kb = band_keys(k, nc)
        vb = band_keys(v, nc)
        key_pos = jnp.arange(nc)[:, None] * CHUNK - WINDOW + jnp.arange((WIN_CHUNKS + 1) * CHUNK)[None, :]
        key_ok = key_pos >= 0
        k_all, v_all = k, v
    else:
        prev = cache_pool
        pos0 = PAST_LEN
        k_all = jnp.concatenate([cache_k, k], axis=1)
        v_all = jnp.concatenate([cache_v, v], axis=1)
        qb, kb, vb = q[:, None], k_all[:, None], v_all[:, None]
        key_ok = jnp.ones((1, k_all.shape[1]), dtype=bool)
    a_out, new_pool = pool_mixer(u, prev, pos0, pool_w, pool_scale)
    b_out = swa_core(qb, kb, vb, key_ok, sink.reshape(SWA_KV_HEADS, SWA_GROUP)).reshape(b, L, SWA_Q_W)
    y = jnp.concatenate([a_out, b_out], axis=-1) @ w_out
    return y, new_pool, k_all[:, -WINDOW:], v_all[:, -WINDOW:]


def diff_core(q, k, v, key_ok, lam, subln_g):
    def amap(qq, kk):
        s = jnp.einsum('bqhd,bkhd->bhqk', qq, kk).astype(jnp.float32) * (HEAD_DIM ** -0.5)
        return jax.nn.softmax(jnp.where(key_ok[None, None], s, -jnp.inf), axis=-1)
    a = amap(q[..., :HEAD_DIM], k[..., :HEAD_DIM]) - lam * amap(q[..., HEAD_DIM:], k[..., HEAD_DIM:])
    o = jnp.einsum('bhqk,bkhd->bqhd', a.astype(v.dtype), v)
    return rmsnorm(o, subln_g)


def odd_mixer(h, w_in, w_out, lam_p, subln_g, ln_g, ln_b, w_s, b_s, cache_k, cache_v, layer_idx):
    b, L, _ = h.shape
    q, k, v, uz, vz = jnp.split(h @ w_in, [DIFF_W, 2 * DIFF_W, 3 * DIFF_W, 3 * DIFF_W + GMLP_W], axis=-1)
    q = q.reshape(b, L, DIFF_HEADS, DIFF_DH)
    k = k.reshape(b, L, DIFF_HEADS, DIFF_DH)
    v = v.reshape(b, L, DIFF_HEADS, DIFF_DH)
    lam_init = 0.8 - 0.6 * math.exp(-0.3 * layer_idx)
    lp = lam_p.astype(jnp.float32)
    lam = jnp.exp(jnp.sum(lp[0] * lp[1])) - jnp.exp(jnp.sum(lp[2] * lp[3])) + lam_init
    if cache_k is None:
        nq = L // QBLK
        kchunk = jnp.arange(L) // CHUNK
        qb = q.reshape(b, nq, QBLK, DIFF_HEADS, DIFF_DH).swapaxes(0, 1)

        def blk(args):
            qi, i = args
            qchunk = (i * QBLK + jnp.arange(QBLK)) // CHUNK
            return diff_core(qi, k, v, kchunk[None, :] <= qchunk[:, None], lam, subln_g)

        o = lax.map(blk, (qb, jnp.arange(nq))).swapaxes(0, 1).reshape(b, L, DIFF_W)
        lc = GMLP_CHUNK
    else:
        kc = jnp.concatenate([cache_k, k], axis=1)
        vc = jnp.concatenate([cache_v, v], axis=1)
        qchunk = (PAST_LEN + jnp.arange(L)) // CHUNK
        kchunk = jnp.arange(kc.shape[1]) // CHUNK
        o = diff_core(q, kc, vc, kchunk[None, :] <= qchunk[:, None], lam, subln_g).reshape(b, L, DIFF_W)
        lc = L
    o = o * (1.0 - lam_init)
    u = jax.nn.gelu(uz, approximate=False)
    vg = layernorm(jax.nn.gelu(vz, approximate=False), ln_g, ln_b)
    nb = L // lc
    vr = vg.reshape(b, nb, lc, GMLP_GROUPS, GMLP_GW)
    ws = jnp.tril(w_s[:, :lc, :lc])
    mix = jnp.einsum('gts,bnsgc->bntgc', ws, vr) + b_s[:, :lc].T[None, None, :, :, None]
    d_out = u * mix.reshape(b, L, GMLP_W)
    y = jnp.concatenate([o, d_out], axis=-1) @ w_out
    return y, k, v, vg


def setup_inputs(seed: int = 0) -> dict:
    key = jax.random.key(seed)
    ks = jax.random.split(key, 25)

    def nrm(k, shape, s):
        return jax.random.normal(k, shape, jnp.float32) * s

    return {
        'x_prompt': nrm(ks[0], (BATCH, SEQ, D_MODEL), 1.0),
        'x_sample': nrm(ks[1], (DEC_BATCH, DEC_SEQ, D_MODEL), 1.0),
        'cache_pool': nrm(ks[2], (N_EVEN, DEC_BATCH, POOL_PAD, POOL_W), 1.0),
        'cache_swa_k': nrm(ks[3], (N_EVEN, DEC_BATCH, WINDOW, SWA_KV_HEADS, HEAD_DIM), 1.0),
        'cache_swa_v': nrm(ks[4], (N_EVEN, DEC_BATCH, WINDOW, SWA_KV_HEADS, HEAD_DIM), 1.0),
        'cache_diff_k': nrm(ks[5], (N_ODD, DEC_BATCH, PAST_LEN, DIFF_HEADS, DIFF_DH), 1.0),
        'cache_diff_v': nrm(ks[6], (N_ODD, DEC_BATCH, PAST_LEN, DIFF_HEADS, DIFF_DH), 1.0),
        'norm_g': 1.0 + nrm(ks[7], (DEPTH, 3, D_MODEL), 0.02),
        'final_g': 1.0 + nrm(ks[8], (D_MODEL,), 0.02),
        'ffn_gate': nrm(ks[9], (DEPTH, 2, D_MODEL, D_FF), D_MODEL ** -0.5),
        'ffn_up': nrm(ks[10], (DEPTH, 2, D_MODEL, D_FF), D_MODEL ** -0.5),
        'ffn_down': nrm(ks[11], (DEPTH, 2, D_FF, D_MODEL), D_FF ** -0.5),
        'even_w_in': nrm(ks[12], (N_EVEN, D_MODEL, EVEN_IN), D_MODEL ** -0.5),
        'even_w_out': nrm(ks[13], (N_EVEN, EVEN_MIX, D_MODEL), EVEN_MIX ** -0.5),
        'pool_w': nrm(ks[14], (N_EVEN, POOL_GROUPS, POOL_GW, POOL_GW), POOL_GW ** -0.5),
        'pool_scale': 1.0 + nrm(ks[15], (N_EVEN, POOL_W), 0.1),
        'swa_sink': nrm(ks[16], (N_EVEN, SWA_HEADS), 1.0),
        'odd_w_in': nrm(ks[17], (N_ODD, D_MODEL, ODD_IN), D_MODEL ** -0.5),
        'odd_w_out': nrm(ks[18], (N_ODD, ODD_MIX, D_MODEL), ODD_MIX ** -0.5),
        'diff_lambda': nrm(ks[19], (N_ODD, 4, HEAD_DIM), 0.1),
        'diff_subln_g': 1.0 + nrm(ks[20], (N_ODD, DIFF_DH), 0.02),
        'gmlp_ln_g': 1.0 + nrm(ks[21], (N_ODD, GMLP_W), 0.02),
        'gmlp_ln_b': nrm(ks[22], (N_ODD, GMLP_W), 0.02),
        'gmlp_w_s': nrm(ks[23], (N_ODD, GMLP_GROUPS, GMLP_CHUNK, GMLP_CHUNK), GMLP_CHUNK ** -0.5),
        'gmlp_b_s': 1.0 + nrm(ks[24], (N_ODD, GMLP_GROUPS, GMLP_CHUNK), 0.1),
    }


def reference(x_prompt, x_sample, cache_pool, cache_swa_k, cache_swa_v, cache_diff_k, cache_diff_v,
              norm_g, final_g, ffn_gate, ffn_up, ffn_down, even_w_in, even_w_out, pool_w, pool_scale,
              swa_sink, odd_w_in, odd_w_out, diff_lambda, diff_subln_g, gmlp_ln_g, gmlp_ln_b,
              gmlp_w_s, gmlp_b_s):
    def trunk(x, prompt):
        pool_s, swa_k, swa_v, diff_k, diff_v, gmlp_v = [], [], [], [], [], []
        for l in range(DEPTH):
            j = l // 2
            x = x + 0.5 * swiglu(rmsnorm(x, norm_g[l, 0]), ffn_gate[l, 0], ffn_up[l, 0], ffn_down[l, 0])
            h = rmsnorm(x, norm_g[l, 1])
            if l % 2 == 0:
                y, sp, sk, sv = even_mixer(h, even_w_in[j], even_w_out[j], pool_w[j], pool_scale[j], swa_sink[j],
                                           None if prompt else cache_pool[j],
                                           None if prompt else cache_swa_k[j],
                                           None if prompt else cache_swa_v[j])
                pool_s.append(sp)
                swa_k.append(sk)
                swa_v.append(sv)
            else:
                y, dk, dv, gv = odd_mixer(h, odd_w_in[j], odd_w_out[j], diff_lambda[j], diff_subln_g[j],
                                          gmlp_ln_g[j], gmlp_ln_b[j], gmlp_w_s[j], gmlp_b_s[j],
                                          None if prompt else cache_diff_k[j],
                                          None if prompt else cache_diff_v[j], l)
                diff_k.append(dk)
                diff_v.append(dv)
                if not prompt:
                    gmlp_v.append(gv)
            x = x + y
            x = x + 0.5 * swiglu(rmsnorm(x, norm_g[l, 2]), ffn_gate[l, 1], ffn_up[l, 1], ffn_down[l, 1])
        return rmsnorm(x, final_g), pool_s, swa_k, swa_v, diff_k, diff_v, gmlp_v

    y_p, pool_p, swa_k_p, swa_v_p, diff_k_p, diff_v_p, _ = trunk(x_prompt, True)
    y_s, pool_s, swa_k_s, swa_v_s, diff_k_s, diff_v_s, gmlp_v_s = trunk(x_sample, False)
    return (y_p, y_s,
            jnp.stack(pool_p), jnp.stack(pool_s),
            jnp.stack(swa_k_p), jnp.stack(swa_k_s),
            jnp.stack(swa_v_p), jnp.stack(swa_v_s),
            jnp.stack(diff_k_p), jnp.stack(diff_k_s),
            jnp.stack(diff_v_p), jnp.stack(diff_v_s),
            jnp.stack(gmlp_v_s))
```

```cpp
#ifndef DBG_REP11
#define DBG_REP11 1
#endif
#ifndef DBG_REP4
#define DBG_REP4 1
#endif
#include <hip/hip_runtime.h>
#include <hip/hip_cooperative_groups.h>
#include <cstdio>
#include <cstdint>
namespace cg = cooperative_groups;
namespace pg8 {
#define PG8_LAS __attribute__((address_space(3)))
typedef unsigned short bf16_t;
typedef short bf16x8 __attribute__((ext_vector_type(8)));
typedef float f32x4 __attribute__((ext_vector_type(4)));
typedef unsigned u32x4 __attribute__((ext_vector_type(4)));
constexpr int BM = 256, BK = 64, HALF = 128, HTB = HALF * BK * 2  , STAGE_BYTES = 8 * HTB, NXCD = 8, WGM = 8;

__host__ __device__ __forceinline__ int lds_byte(int r, int c) { const int st = (r >> 4) * 2 + (c >> 5), rr = r & 15, cc = c & 31, ob = rr * 64 + cc * 2; return st * 1024 + (ob ^ (((ob >> 9) & 1) << 5)); }
__host__ __device__ __forceinline__ void stage_rc(int b, int& R, int& C) { const int st = b / 1024, sb = b % 1024, swz = sb ^ (((sb >> 9) & 1) << 5); R = (st >> 1) * 16 + swz / 64; C = (st & 1) * 32 + (swz % 64) / 2; }
__host__ __device__ __forceinline__ int perm32(int rho) { const int n = rho >> 4, i = rho & 15; return 8 * (i >> 2) + 4 * n + (i & 3); }

struct Unit { int pm, pn, koff; };
struct Gemm { const bf16_t* A; const bf16_t* Bt; int M, N, K, ld; };

struct StaticOrder {
    int nM, nN, nwg, G, c;
    __host__ __device__ void init(int M, int N, int G_, int c_) { nM = M / BM; nN = N / BM; nwg = nM * nN; G = G_; c = c_; }
    __host__ __device__ bool next(int i, Unit& u) const {
        const long L = (long)i * G + c; if (L >= nwg) return false;
        int wgid = (int)L; { const int q = nwg / NXCD, r = nwg % NXCD, xcd = wgid % NXCD, off = wgid / NXCD; wgid = (xcd < r ? xcd * (q + 1) : r * (q + 1) + (xcd - r) * q) + off; }
        const int nig = WGM * nN, gid = wgid / nig, fm = gid * WGM, gsz = (nM - fm) < WGM ? (nM - fm) : WGM;
        u.pm = fm + ((wgid % nig) % gsz); u.pn = (wgid % nig) / gsz; u.koff = 0; return true;
    }
    __device__ __forceinline__ void a_ready(const Unit&) const {}
    __device__ __forceinline__ void done(const Unit&) const {}
};

struct TailOrder {
    int G, c, ksub;
    __host__ __device__ void init(int ksub_, int G_, int c_) { G = G_; c = c_; ksub = ksub_; }
    __host__ __device__ bool next(int i, Unit& u) const {
        const int L = i * G + c; if (L >= 176) return false;
        const int uid = L / 11, ks = L % 11; u.pm = 128 + (uid >> 2); u.pn = uid & 3; u.koff = ks * ksub * 2; return true;
    }
    __device__ __forceinline__ void a_ready(const Unit&) const {}
    __device__ __forceinline__ void done(const Unit&) const {}
};
__device__ __forceinline__ unsigned cvt_pk_bf16(float lo, float hi) { unsigned r; asm volatile("v_cvt_pk_bf16_f32 %0, %1, %2" : "=v"(r) : "v"(lo), "v"(hi)); return r; }
typedef float f32x2 __attribute__((ext_vector_type(2)));
__device__ __forceinline__ float row_rstd(const float* ssq, int row) {
    const f32x4* p = (const f32x4*)(ssq + (size_t)row * 16);
    const f32x4 a = p[0], b = p[1], c = p[2], d = p[3];
    const float s = (((a[0] + a[1]) + (a[2] + a[3])) + ((b[0] + b[1]) + (b[2] + b[3]))) + (((c[0] + c[1]) + (c[2] + c[3])) + ((d[0] + d[1]) + (d[2] + d[3])));
    return 1.0f / sqrtf(s * (1.0f / 1024.0f) + 1e-6f);
}
__device__ __forceinline__ float row_rstd4(const float* ssq, int row, int fq) {
    const f32x4 a = *((const f32x4*)(ssq + (size_t)row * 16) + fq);
    float s = (a[0] + a[1]) + (a[2] + a[3]);
    s += __shfl_xor(s, 16); s += __shfl_xor(s, 32);
    return 1.0f / sqrtf(s * (1.0f / 1024.0f) + 1e-6f);
}
__device__ __forceinline__ float silu_mul(float g, float up) { return (g * up) * __builtin_amdgcn_rcpf(1.0f + __builtin_amdgcn_exp2f(g * -1.4426950408889634f)); }
struct EpiGU {
    static constexpr bool PERM = true, AFTER_DRAIN = false;
    bf16_t* H; const float* ssq;
    __device__ __forceinline__ void operator()(const f32x4 (&acc)[2][2][4][2], const Unit& u, int wr, int wc, int fr, int fq) const {
        const int row0 = u.pm * BM + wr * 64 + fr, col0 = u.pn * HALF + wc * 32 + 8 * fq;
#pragma unroll
        for (int ai = 0; ai < 2; ++ai)
#pragma unroll
            for (int m = 0; m < 4; ++m) { const int row = row0 + ai * HALF + m * 16; const float rs = row_rstd4(ssq, row, fq);
                float h[8];
#pragma unroll
                for (int n = 0; n < 2; ++n)
#pragma unroll
                    for (int i = 0; i < 4; ++i) { const float g = acc[ai][0][m][n][i] * rs, up = acc[ai][1][m][n][i] * rs; h[4 * n + i] = silu_mul(g, up); }
                u32x4 w; w.x = cvt_pk_bf16(h[0], h[1]); w.y = cvt_pk_bf16(h[2], h[3]); w.z = cvt_pk_bf16(h[4], h[5]); w.w = cvt_pk_bf16(h[6], h[7]);
                *(u32x4*)(H + (size_t)row * 2816 + col0) = w; if (m & 1) asm volatile("" ::: "memory"); }
    }
};
struct EpiRes {
    static constexpr bool PERM = true, AFTER_DRAIN = false;
    const float* base; float* X; bf16_t* XB; float* ssq; float alpha;
    __device__ __forceinline__ void operator()(const f32x4 (&acc)[2][2][4][2], const Unit& u, int wr, int wc, int fr, int fq) const {
        const int row0 = u.pm * BM + wr * 64 + fr, col0 = u.pn * BM + wc * 32 + 8 * fq;
#pragma unroll
        for (int ai = 0; ai < 2; ++ai)
#pragma unroll
            for (int m = 0; m < 4; ++m) { const int row = row0 + ai * HALF + m * 16; float sq = 0.f;
#pragma unroll
                for (int bj = 0; bj < 2; ++bj) { const size_t off = (size_t)row * 1024 + col0 + bj * HALF;
                    const f32x4 b0 = *(const f32x4*)(base + off), b1 = *(const f32x4*)(base + off + 4);
                    const f32x4 x0 = b0 + acc[ai][bj][m][0] * alpha, x1 = b1 + acc[ai][bj][m][1] * alpha;
                    *(f32x4*)(X + off) = x0; *(f32x4*)(X + off + 4) = x1;
                    u32x4 w; w.x = cvt_pk_bf16(x0[0], x0[1]); w.y = cvt_pk_bf16(x0[2], x0[3]); w.z = cvt_pk_bf16(x1[0], x1[1]); w.w = cvt_pk_bf16(x1[2], x1[3]);
                    *(u32x4*)(XB + off) = w;
                    sq += ((x0[0] * x0[0] + x0[1] * x0[1]) + (x0[2] * x0[2] + x0[3] * x0[3])) + ((x1[0] * x1[0] + x1[1] * x1[1]) + (x1[2] * x1[2] + x1[3] * x1[3])); }
                sq += __shfl_xor(sq, 16); sq += __shfl_xor(sq, 32);
                if (fq == 0) ssq[(size_t)row * 16 + u.pn * 4 + wc] = sq; if (m & 1) asm volatile("" ::: "memory"); }
    }
};
struct EpiPart {
    static constexpr bool PERM = true, AFTER_DRAIN = false;
    float* P; float alpha; int ksub2;
    __device__ __forceinline__ void operator()(const f32x4 (&acc)[2][2][4][2], const Unit& u, int wr, int wc, int fr, int fq) const {
        const int ks = u.koff / ksub2;
        const int row0 = (u.pm - 128) * BM + wr * 64 + fr, col0 = u.pn * BM + wc * 32 + 8 * fq;
        float* pb = P + ((size_t)ks * 1024 + row0) * 1024 + col0;
#pragma unroll
        for (int ai = 0; ai < 2; ++ai)
#pragma unroll
            for (int m = 0; m < 4; ++m) {
#pragma unroll
                for (int bj = 0; bj < 2; ++bj) { float* pp = pb + (size_t)(ai * HALF + m * 16) * 1024 + bj * HALF;
                    *(f32x4*)pp = acc[ai][bj][m][0] * alpha; *(f32x4*)(pp + 4) = acc[ai][bj][m][1] * alpha; } }
    }
};
struct EpiIn {
    static constexpr bool PERM = true, AFTER_DRAIN = false;
    bf16_t* E; int ldc; const float* ssq; float* fk; float* fv;
    __device__ __forceinline__ void operator()(const f32x4 (&acc)[2][2][4][2], const Unit& u, int wr, int wc, int fr, int fq) const {
        const int row0 = u.pm * BM + wr * 64 + fr, col0 = u.pn * BM + wc * 32 + 8 * fq;
        float* fo = nullptr; int fcol0 = 0;
        if (fk) { if (u.pn >= 4 && u.pn < 8) { fo = fk; fcol0 = col0 - 1024; } else if (u.pn >= 8 && u.pn < 12) { fo = fv; fcol0 = col0 - 2048; } }
#pragma unroll
        for (int ai = 0; ai < 2; ++ai)
#pragma unroll
            for (int m = 0; m < 4; ++m) { const int row = row0 + ai * HALF + m * 16; const float rs = row_rstd4(ssq, row, fq);
#pragma unroll
                for (int bj = 0; bj < 2; ++bj) { const f32x4 v0 = acc[ai][bj][m][0] * rs, v1 = acc[ai][bj][m][1] * rs;
                    u32x4 w; w.x = cvt_pk_bf16(v0[0], v0[1]); w.y = cvt_pk_bf16(v0[2], v0[3]); w.z = cvt_pk_bf16(v1[0], v1[1]); w.w = cvt_pk_bf16(v1[2], v1[3]);
                    *(u32x4*)(E + (size_t)row * ldc + col0 + bj * HALF) = w;
                    if (fo) { float* fp = fo + (size_t)row * 1024 + fcol0 + bj * HALF; *(f32x4*)fp = v0; *(f32x4*)(fp + 4) = v1; } } asm volatile("" ::: "memory"); }
    }
};
template <class Epi, class Sched, bool ALIGN_EPI = false, bool SP2 = false>
__device__ __forceinline__ void gemm_phase(PG8_LAS unsigned char* lds, const Gemm g, const Sched& S, const Epi& E) {
    const int tid = threadIdx.x, wid = __builtin_amdgcn_readfirstlane(tid >> 6), lane = tid & 63, wr = wid >> 2, wc = wid & 3, fr = lane & 15, fq = lane >> 4;
    const int K = g.ld, nt = g.K / BK;
    unsigned voffA[2], voffB[2];
#pragma unroll
    for (int i = 0; i < 2; ++i) { int R, C; stage_rc(tid * 16 + i * 8192, R, C); const int Rb = Epi::PERM ? ((R & ~31) + perm32(R & 31)) : R;
        voffA[i] = (unsigned)(R * K + C) * 2u; voffB[i] = (unsigned)(Rb * K + C) * 2u; }
    const size_t kstep = (size_t)(BK * 2);
    const size_t hstep = (size_t)HALF * K * 2;
    const size_t tstep = 2 * hstep;
    const unsigned ldsw = (unsigned)wid * 1024u;
    const int aoff = lds_byte(wr * 64 + fr, fq * 8), boff = lds_byte(wc * 32 + fr, fq * 8);
#define PG8_SA(b, h) (((b) * 2 + (h)) * HTB)
#define PG8_SB(b, h) ((4 + (b) * 2 + (h)) * HTB)
#define PG8_STAGE(bufoff, gbase, voff) do { _Pragma("unroll") for (int _i = 0; _i < 2; ++_i) \
        __builtin_amdgcn_global_load_lds((const unsigned*)((const char*)(gbase) + (voff)[_i]), (PG8_LAS unsigned*)(lds + (bufoff) + ldsw + _i * 8192), 16, 0, 0); } while (0)
#define PG8_LDA(dst, b, h) do { _Pragma("unroll") for (int m = 0; m < 4; ++m) _Pragma("unroll") for (int k = 0; k < 2; ++k) dst[m][k] = *(const PG8_LAS bf16x8*)(lds + PG8_SA(b, h) + aoff + m * 2048 + k * 1024); } while (0)
#define PG8_LDB(dst, b, h) do { _Pragma("unroll") for (int n = 0; n < 2; ++n) _Pragma("unroll") for (int k = 0; k < 2; ++k) dst[n][k] = *(const PG8_LAS bf16x8*)(lds + PG8_SB(b, h) + boff + n * 2048 + k * 1024); } while (0)
#define PG8_MMA(ai, bj, At, Bt) do { __builtin_amdgcn_s_setprio(1); _Pragma("unroll") for (int m = 0; m < 4; ++m) _Pragma("unroll") for (int n = 0; n < 2; ++n) _Pragma("unroll") for (int k = 0; k < 2; ++k) \
        acc[ai][bj][m][n] = __builtin_amdgcn_mfma_f32_16x16x32_bf16(Bt[n][k], At[m][k], acc[ai][bj][m][n], 0, 0, 0); __builtin_amdgcn_s_setprio(0); } while (0)
#define PG8_WAIT_V(n) asm volatile("s_waitcnt vmcnt(" #n ")" ::: "memory")
#define PG8_WAIT_L(n) asm volatile("s_waitcnt lgkmcnt(" #n ")" ::: "memory")
#define PG8_BAR __builtin_amdgcn_s_barrier()
#define PG8_SCHED __builtin_amdgcn_sched_barrier(0)
    Unit cur, nxt; int ui = 0;
    if (!S.next(0, cur)) return;
    f32x4 acc[2][2][4][2];
#pragma unroll
    for (int a = 0; a < 2; ++a)
#pragma unroll
        for (int b = 0; b < 2; ++b)
#pragma unroll
            for (int m = 0; m < 4; ++m)
#pragma unroll
                for (int n = 0; n < 2; ++n) acc[a][b][m][n] = (f32x4){0.f, 0.f, 0.f, 0.f};
    bf16x8 At[4][2], B0[2][2], B1[2][2];
    const char* cA = (const char*)g.A + (size_t)cur.pm * tstep + cur.koff; const char* cB = (const char*)g.Bt + (size_t)cur.pn * tstep + cur.koff;
    S.a_ready(cur);
    if constexpr (SP2) {
        PG8_STAGE(PG8_SB(0, 0), cB, voffB); PG8_STAGE(PG8_SB(0, 1), cB + hstep, voffB); PG8_STAGE(PG8_SA(0, 0), cA, voffA); PG8_STAGE(PG8_SA(0, 1), cA + hstep, voffA);
        if (wr == 1) PG8_BAR;
        PG8_WAIT_V(2); PG8_BAR;
        PG8_STAGE(PG8_SB(1, 0), cB + kstep, voffB); PG8_STAGE(PG8_SA(1, 0), cA + kstep, voffA); PG8_STAGE(PG8_SB(1, 1), cB + hstep + kstep, voffB);
        PG8_WAIT_V(6); PG8_BAR;
    } else {
        PG8_STAGE(PG8_SB(0, 0), cB, voffB); PG8_STAGE(PG8_SA(0, 0), cA, voffA); PG8_STAGE(PG8_SB(0, 1), cB + hstep, voffB); PG8_STAGE(PG8_SA(0, 1), cA + hstep, voffA);
        if (wr == 1) PG8_BAR;
        PG8_WAIT_V(4); PG8_BAR;
        PG8_STAGE(PG8_SB(1, 0), cB + kstep, voffB); PG8_STAGE(PG8_SA(1, 0), cA + kstep, voffA); PG8_STAGE(PG8_SB(1, 1), cB + hstep + kstep, voffB);
        PG8_WAIT_V(6); PG8_BAR;
    }
    for (;;) {
        const bool has_next = S.next(ui + 1, nxt);
        const char* nA = has_next ? (const char*)g.A + (size_t)nxt.pm * tstep + nxt.koff : cA; const char* nB = has_next ? (const char*)g.Bt + (size_t)nxt.pn * tstep + nxt.koff : cB;
        for (int t = 0; t < nt; t += 2) {
            const bool last = (t == nt - 2);
            const char* a1 = cA + (size_t)(t + 1) * kstep;
            const char* a2 = last ? nA : cA + (size_t)(t + 2) * kstep; const char* b2 = last ? nB : cB + (size_t)(t + 2) * kstep;
            const char* a3 = a2 + kstep; const char* b3 = b2 + kstep;
            if (last && has_next) S.a_ready(nxt);
            if constexpr (SP2) {
            PG8_LDB(B0, 0, 0); PG8_LDB(B1, 0, 1); PG8_SCHED; PG8_LDA(At, 0, 0); PG8_STAGE(PG8_SA(1, 1), a1 + hstep, voffA);
            PG8_WAIT_V(8); PG8_WAIT_L(0); PG8_BAR; PG8_MMA(0, 0, At, B0); PG8_MMA(0, 1, At, B1); PG8_BAR; PG8_SCHED;
            PG8_LDA(At, 0, 1); PG8_STAGE(PG8_SB(0, 0), b2, voffB); PG8_STAGE(PG8_SB(0, 1), b2 + hstep, voffB); PG8_STAGE(PG8_SA(0, 0), a2, voffA);
            PG8_WAIT_V(8); PG8_WAIT_L(0); PG8_BAR; PG8_MMA(1, 0, At, B0); PG8_MMA(1, 1, At, B1); PG8_BAR; PG8_SCHED;
            PG8_LDB(B0, 1, 0); PG8_LDB(B1, 1, 1); PG8_SCHED; PG8_LDA(At, 1, 0); PG8_STAGE(PG8_SA(0, 1), a2 + hstep, voffA);
            PG8_WAIT_V(8); PG8_WAIT_L(0); PG8_BAR; PG8_MMA(0, 0, At, B0); PG8_MMA(0, 1, At, B1); PG8_BAR; PG8_SCHED;
            PG8_LDA(At, 1, 1); PG8_STAGE(PG8_SB(1, 0), b3, voffB); PG8_STAGE(PG8_SB(1, 1), b3 + hstep, voffB); PG8_STAGE(PG8_SA(1, 0), a3, voffA);
            PG8_WAIT_V(8); PG8_WAIT_L(0); PG8_BAR; PG8_MMA(1, 0, At, B0); PG8_MMA(1, 1, At, B1); PG8_BAR; PG8_SCHED;
            } else {
            PG8_LDB(B0, 0, 0); PG8_SCHED; PG8_LDA(At, 0, 0); PG8_STAGE(PG8_SA(1, 1), a1 + hstep, voffA);
            PG8_WAIT_L(8); PG8_BAR; PG8_WAIT_L(0); PG8_MMA(0, 0, At, B0); PG8_BAR; PG8_SCHED;
            PG8_LDB(B1, 0, 1); PG8_STAGE(PG8_SB(0, 0), b2, voffB);
            PG8_BAR; PG8_WAIT_L(0); PG8_MMA(0, 1, At, B1); PG8_BAR;
            PG8_LDA(At, 0, 1); PG8_STAGE(PG8_SA(0, 0), a2, voffA);
            PG8_BAR; PG8_WAIT_L(0); PG8_MMA(1, 0, At, B0); PG8_BAR; PG8_SCHED;
            PG8_STAGE(PG8_SB(0, 1), b2 + hstep, voffB);
            PG8_WAIT_V(6); PG8_BAR; PG8_MMA(1, 1, At, B1); PG8_BAR;
            PG8_LDB(B0, 1, 0); PG8_SCHED; PG8_LDA(At, 1, 0); PG8_STAGE(PG8_SA(0, 1), a2 + hstep, voffA);
            PG8_WAIT_L(8); PG8_BAR; PG8_WAIT_L(0); PG8_MMA(0, 0, At, B0); PG8_BAR; PG8_SCHED;
            PG8_LDB(B1, 1, 1); PG8_STAGE(PG8_SB(1, 0), b3, voffB);
            PG8_BAR; PG8_WAIT_L(0); PG8_MMA(0, 1, At, B1); PG8_BAR;
            PG8_LDA(At, 1, 1); PG8_STAGE(PG8_SA(1, 0), a3, voffA);
            PG8_BAR; PG8_WAIT_L(0); PG8_MMA(1, 0, At, B0); PG8_BAR; PG8_SCHED;
            PG8_STAGE(PG8_SB(1, 1), b3 + hstep, voffB);
            PG8_WAIT_V(6); PG8_BAR; PG8_MMA(1, 1, At, B1); PG8_BAR;
            }
        }
        if constexpr (ALIGN_EPI) { if (wr == 0) PG8_BAR; }
        if constexpr (!Epi::AFTER_DRAIN) { E(acc, cur, wr, wc, fr, fq); S.done(cur); }
        if (!has_next) break;
#pragma unroll
        for (int a = 0; a < 2; ++a)
#pragma unroll
            for (int b = 0; b < 2; ++b)
#pragma unroll
                for (int m = 0; m < 4; ++m)
#pragma unroll
                    for (int n = 0; n < 2; ++n) acc[a][b][m][n] = (f32x4){0.f, 0.f, 0.f, 0.f};
        cur = nxt; cA = nA; cB = nB; ++ui;
        if constexpr (ALIGN_EPI) { if (wr == 1) PG8_BAR; }
    }
    PG8_WAIT_V(0);
    if constexpr (!ALIGN_EPI) { if (wr == 0) PG8_BAR; }
    PG8_BAR;
    if constexpr (Epi::AFTER_DRAIN) { E.fused(acc, cur, wr, wc, fr, fq, lds, wid, lane); S.done(cur); }
#undef PG8_SA
#undef PG8_SB
#undef PG8_STAGE
#undef PG8_LDA
#undef PG8_LDB
#undef PG8_MMA
#undef PG8_WAIT_V
#undef PG8_WAIT_L
#undef PG8_BAR
#undef PG8_SCHED
}
}
#define DI __device__ __forceinline__
#define LAS __attribute__((address_space(3)))
typedef unsigned short bf16;
typedef short bf16x8 __attribute__((ext_vector_type(8)));
typedef float f32x4 __attribute__((ext_vector_type(4)));
typedef float f32x16 __attribute__((ext_vector_type(16)));
typedef unsigned u32x4 __attribute__((ext_vector_type(4)));
typedef unsigned u32x2 __attribute__((ext_vector_type(2)));
typedef short v4i16_t __attribute__((ext_vector_type(4)));
typedef LAS unsigned char* ldsp;
typedef LAS const unsigned char* cldsp;
constexpr int NWAVES = 8, NTHR = 512;
constexpr int TP = 32768, TS = 1024, T = TP + TS, DM = 1024, FF = 2816;
constexpr int E0W = 1792, E1W = 3840, MIX0W = 1408, MIX1W = 1408;
constexpr size_t O_Y = 0, O_POOLP = (size_t)T * 1024, O_POOLS = O_POOLP + 8 * 15 * 384, O_SKP = O_POOLS + 16 * 15 * 384, O_SKS = O_SKP + 8 * 128 * 128,
    O_SVP = O_SKS + 16 * 128 * 128, O_SVS = O_SVP + 8 * 128 * 128, O_DK = O_SVS + 16 * 128 * 128, O_DV = O_DK + (size_t)T * 1024, O_GV = O_DV + (size_t)T * 1024, O_END = O_GV + 16 * 64 * 384;
constexpr size_t MiB = 1u << 20;
constexpr size_t WS_WGU = 2 * MiB, WS_WD = 46 * MiB, WS_WEI = 68 * MiB, WS_WEO = 72 * MiB, WS_WOI = 75 * MiB, WS_WOO = 83 * MiB, WS_SSQ = 87 * MiB, WS_XB = 90 * MiB,
    WS_H = 156 * MiB, WS_E = 338 * MiB, WS_MIX = 586 * MiB, WS_PART = 702 * MiB, WS_END = 746 * MiB;
constexpr size_t WGU_STRIDE = (size_t)5632 * 1024, WD_STRIDE = (size_t)1024 * 2816;
static_assert(WS_WGU + 4 * WGU_STRIDE * 2 <= WS_WD && WS_WD + 4 * WD_STRIDE * 2 <= WS_WEI && WS_WEI + (size_t)1792 * 1024 * 2 <= WS_WEO && WS_WEO + (size_t)1024 * 1408 * 2 <= WS_WOI &&
              WS_WOI + (size_t)3840 * 1024 * 2 <= WS_WOO && WS_WOO + (size_t)1024 * 1792 * 2 <= WS_SSQ && WS_SSQ + (size_t)T * 16 * 4 <= WS_XB && WS_XB + (size_t)T * 1024 * 2 <= WS_H &&
              WS_H + (size_t)T * FF * 2 <= WS_E && WS_E + (size_t)T * E1W * 2 <= WS_MIX && WS_MIX + (size_t)T * MIX1W * 2 <= WS_PART && WS_PART + (size_t)11 * 1024 * 1024 * 4 <= WS_END, "workspace map");
constexpr int RING_BYTES = 131072, LDS_BYTES = 147456, LDSCTL_OFF = LDS_BYTES - 1024;
constexpr float LOG2E = 1.4426950408889634f;
constexpr float C2 = 0.125f * LOG2E;

DI unsigned f2bf(float f) { unsigned u = __builtin_bit_cast(unsigned, f); return (u + 0x7fffu + ((u >> 16) & 1u)) >> 16; }
typedef float f32x2_t __attribute__((ext_vector_type(2))); typedef __bf16 bf16x2_t __attribute__((ext_vector_type(2)));
DI unsigned pk2(float lo, float hi) { const f32x2_t v = {lo, hi}; const bf16x2_t b = __builtin_convertvector(v, bf16x2_t); return __builtin_bit_cast(unsigned, b); }
DI float bf2f(unsigned short b) { return __builtin_bit_cast(float, (unsigned)b << 16); }
DI float bflo(unsigned w) { return __builtin_bit_cast(float, w << 16); }
DI float bfhi(unsigned w) { return __builtin_bit_cast(float, w & 0xffff0000u); }
DI u32x4 pack8(f32x4 a, f32x4 b) { u32x4 w; w.x = pk2(a[0], a[1]); w.y = pk2(a[2], a[3]); w.z = pk2(b[0], b[1]); w.w = pk2(b[2], b[3]); return w; }
DI int fresh_tid() { int t = threadIdx.x; asm volatile("" : "+v"(t)); return t; }
DI bf16x8 scale_q(bf16x8 v) {
    const u32x4 w = __builtin_bit_cast(u32x4, v); u32x4 r;
    r.x = pk2(bflo(w.x) * C2, bfhi(w.x) * C2); r.y = pk2(bflo(w.y) * C2, bfhi(w.y) * C2); r.z = pk2(bflo(w.z) * C2, bfhi(w.z) * C2); r.w = pk2(bflo(w.w) * C2, bfhi(w.w) * C2);
    return __builtin_bit_cast(bf16x8, r);
}
DI float wave_sum(float v) {
#pragma unroll
    for (int o = 1; o < 64; o <<= 1) v += __shfl_xor(v, o);
    return v;
}
DI float gelu_erf(float v) {
    const float av = fabsf(v), t = __builtin_amdgcn_rcpf(av * 0.2316418882f + 1.0f);
    float q = t * 0.5307027145f + (-0.7265760135f); q = q * t + 0.7107068705f; q = q * t + (-0.142248368f); q = q * t + 0.127414796f; q = q * t;
    const float e = __builtin_amdgcn_exp2f((v * v) * (-0.72134752044f));
    const float m = v * (q * e);
    return v < 0.f ? m : v - m;
}
#define MFMA32(a, b, c) __builtin_amdgcn_mfma_f32_32x32x16_bf16((a), (b), (c), 0, 0, 0)
DI f32x16 zero16() { f32x16 z; for (int i = 0; i < 16; ++i) z[i] = 0.f; return z; }
DI v4i16_t vtr(cldsp p) { return __builtin_amdgcn_ds_read_tr16_b64_v4i16((LAS v4i16_t*)p); }

struct Args { const float* in[25]; float* out; unsigned char* ws; int ph_lo, ph_hi; };

template <int NDB, int VSTR>
DI void attn_tile(float& m, f32x16& negm, float& l, f32x16 (&o)[NDB], cldsp Kt, int cb, cldsp Vlane, const bf16x8 (&q)[4], int r32, int hi, bool first) {
    f32x16 p0, p1;
#pragma unroll
    for (int hf = 0; hf < 2; ++hf) {
        bf16x8 kf[4];
#pragma unroll
        for (int dd = 0; dd < 2; ++dd) { const int d0 = 2 * hf + dd;
            const int chk = cb + 2 * d0 + hi;
            kf[2 * dd] = *(const LAS bf16x8*)(Kt + chk * 1024 + ((r32 ^ (chk & 15)) * 16));
            kf[2 * dd + 1] = *(const LAS bf16x8*)(Kt + chk * 1024 + (((32 + r32) ^ (chk & 15)) * 16)); }
#pragma unroll
        for (int dd = 0; dd < 2; ++dd) { if (hf == 0 && dd == 0) { p0 = MFMA32(kf[0], q[0], negm); p1 = MFMA32(kf[1], q[0], negm); } else { p0 = MFMA32(kf[2 * dd], q[2 * hf + dd], p0); p1 = MFMA32(kf[2 * dd + 1], q[2 * hf + dd], p1); } }
    }
    v4i16_t vf[2][4][2];
#pragma unroll
    for (int ks = 0; ks < 4; ++ks) { vf[0][ks][0] = vtr(Vlane + (16 * ks) * VSTR); vf[0][ks][1] = vtr(Vlane + (16 * ks + 8) * VSTR); }
    __builtin_amdgcn_sched_barrier(0);
    float mx = fmaxf(p0[0], p1[0]);
#pragma unroll
    for (int r = 1; r < 16; ++r) mx = fmaxf(mx, fmaxf(p0[r], p1[r]));
    { const auto rr = __builtin_amdgcn_permlane32_swap(__float_as_uint(mx), __float_as_uint(mx), false, false); mx = fmaxf(__uint_as_float(rr[0]), __uint_as_float(rr[1])); }
    if (first || __any(mx > 8.0f)) {
        const float delta = first ? mx : fmaxf(mx, 0.f);
        m += delta;
#pragma unroll
        for (int r = 0; r < 16; ++r) { p0[r] -= delta; p1[r] -= delta; }
        if (!first) { const float alpha = __builtin_amdgcn_exp2f(-delta); l *= alpha;
#pragma unroll
            for (int db = 0; db < NDB; ++db) o[db] = o[db] * alpha; }
#pragma unroll
        for (int r = 0; r < 16; ++r) negm[r] = -m;
    }
    float rs = 0.f;
#pragma unroll
    for (int r = 0; r < 16; ++r) { p0[r] = __builtin_amdgcn_exp2f(p0[r]); p1[r] = __builtin_amdgcn_exp2f(p1[r]); rs += p0[r] + p1[r]; }
    l += rs;
    bf16x8 pb[4];
#pragma unroll
    for (int s = 0; s < 2; ++s) {
        u32x4 w0, w1;
        w0.x = pk2(p0[8 * s + 0], p0[8 * s + 1]); w0.y = pk2(p0[8 * s + 2], p0[8 * s + 3]); w0.z = pk2(p0[8 * s + 4], p0[8 * s + 5]); w0.w = pk2(p0[8 * s + 6], p0[8 * s + 7]);
        w1.x = pk2(p1[8 * s + 0], p1[8 * s + 1]); w1.y = pk2(p1[8 * s + 2], p1[8 * s + 3]); w1.z = pk2(p1[8 * s + 4], p1[8 * s + 5]); w1.w = pk2(p1[8 * s + 6], p1[8 * s + 7]);
        pb[s] = __builtin_bit_cast(bf16x8, w0); pb[2 + s] = __builtin_bit_cast(bf16x8, w1);
    }
    __builtin_amdgcn_sched_barrier(0);
#pragma unroll
    for (int db = 0; db < NDB; ++db) {
        if (db + 1 < NDB) {
#pragma unroll
            for (int ks = 0; ks < 4; ++ks) { vf[(db + 1) & 1][ks][0] = vtr(Vlane + (16 * ks) * VSTR + (db + 1) * 64); vf[(db + 1) & 1][ks][1] = vtr(Vlane + (16 * ks + 8) * VSTR + (db + 1) * 64); }
        }
#pragma unroll
        for (int ks = 0; ks < 4; ++ks) {
            const bf16x8 a = __builtin_shufflevector(vf[db & 1][ks][0], vf[db & 1][ks][1], 0, 1, 2, 3, 4, 5, 6, 7);
            o[db] = MFMA32(a, pb[ks], o[db]);
        }
        __builtin_amdgcn_sched_barrier(0);
    }
}
template <int NDB>
DI void qk_part(float& m, f32x16& negm, float& l, f32x16 (&o)[NDB], bf16x8 (&pb)[4], cldsp Kt, int cb, const bf16x8 (&q)[4], int r32, int hi, bool first) {
    f32x16 p0, p1;
#pragma unroll
    for (int hf = 0; hf < 2; ++hf) {
        bf16x8 kf[4];
#pragma unroll
        for (int dd = 0; dd < 2; ++dd) { const int d0 = 2 * hf + dd; const int chk = cb + 2 * d0 + hi;
            kf[2 * dd] = *(const LAS bf16x8*)(Kt + chk * 1024 + ((r32 ^ (chk & 15)) * 16));
            kf[2 * dd + 1] = *(const LAS bf16x8*)(Kt + chk * 1024 + (((32 + r32) ^ (chk & 15)) * 16)); }
#pragma unroll
        for (int dd = 0; dd < 2; ++dd) { if (hf == 0 && dd == 0) { p0 = MFMA32(kf[0], q[0], negm); p1 = MFMA32(kf[1], q[0], negm); } else { p0 = MFMA32(kf[2 * dd], q[2 * hf + dd], p0); p1 = MFMA32(kf[2 * dd + 1], q[2 * hf + dd], p1); } }
    }
    float mx = fmaxf(p0[0], p1[0]);
#pragma unroll
    for (int r = 1; r < 16; ++r) mx = fmaxf(mx, fmaxf(p0[r], p1[r]));
    { const auto rr = __builtin_amdgcn_permlane32_swap(__float_as_uint(mx), __float_as_uint(mx), false, false); mx = fmaxf(__uint_as_float(rr[0]), __uint_as_float(rr[1])); }
    if (first || __any(mx > 8.0f)) {
        const float delta = first ? mx : fmaxf(mx, 0.f);
        m += delta;
#pragma unroll
        for (int r = 0; r < 16; ++r) { p0[r] -= delta; p1[r] -= delta; }
        if (!first) { const float alpha = __builtin_amdgcn_exp2f(-delta); l *= alpha;
#pragma unroll
            for (int db = 0; db < NDB; ++db) o[db] = o[db] * alpha; }
#pragma unroll
        for (int r = 0; r < 16; ++r) negm[r] = -m;
    }
    float rs = 0.f;
#pragma unroll
    for (int r = 0; r < 16; ++r) { p0[r] = __builtin_amdgcn_exp2f(p0[r]); p1[r] = __builtin_amdgcn_exp2f(p1[r]); rs += p0[r] + p1[r]; }
    l += rs;
#pragma unroll
    for (int s = 0; s < 2; ++s) {
        u32x4 w0, w1;
        w0.x = pk2(p0[8 * s + 0], p0[8 * s + 1]); w0.y = pk2(p0[8 * s + 2], p0[8 * s + 3]); w0.z = pk2(p0[8 * s + 4], p0[8 * s + 5]); w0.w = pk2(p0[8 * s + 6], p0[8 * s + 7]);
        w1.x = pk2(p1[8 * s + 0], p1[8 * s + 1]); w1.y = pk2(p1[8 * s + 2], p1[8 * s + 3]); w1.z = pk2(p1[8 * s + 4], p1[8 * s + 5]); w1.w = pk2(p1[8 * s + 6], p1[8 * s + 7]);
        pb[s] = __builtin_bit_cast(bf16x8, w0); pb[2 + s] = __builtin_bit_cast(bf16x8, w1);
    }
}
template <int NDB, int VSTR>
DI void pv_part(f32x16 (&o)[NDB], cldsp Vlane, const bf16x8 (&pb)[4]) {
    v4i16_t vf[2][4][2];
#pragma unroll
    for (int ks = 0; ks < 4; ++ks) { vf[0][ks][0] = vtr(Vlane + (16 * ks) * VSTR); vf[0][ks][1] = vtr(Vlane + (16 * ks + 8) * VSTR); }
#pragma unroll
    for (int db = 0; db < NDB; ++db) {
        if (db + 1 < NDB) {
#pragma unroll
            for (int ks = 0; ks < 4; ++ks) { vf[(db + 1) & 1][ks][0] = vtr(Vlane + (16 * ks) * VSTR + (db + 1) * 64); vf[(db + 1) & 1][ks][1] = vtr(Vlane + (16 * ks + 8) * VSTR + (db + 1) * 64); }
        }
#pragma unroll
        for (int ks = 0; ks < 4; ++ks) {
            const bf16x8 a = __builtin_shufflevector(vf[db & 1][ks][0], vf[db & 1][ks][1], 0, 1, 2, 3, 4, 5, 6, 7);
            o[db] = MFMA32(a, pb[ks], o[db]);
        }
        __builtin_amdgcn_sched_barrier(0);
    }
}
DI void transpose_item(const float* W, int K, int N, const float* gain, bf16* WT, int item, int lane, LAS float* scr, int mode) {
    const int nblk = N / 32, kb = item / nblk, nb = item % nblk, k0 = 64 * kb, n0 = 32 * nb;
#pragma unroll
    for (int i = 0; i < 8; ++i) { const int kk = 8 * i + (lane >> 3), n4 = (lane & 7) * 4;
        const f32x4 v = *(const f32x4*)(W + (size_t)(k0 + kk) * N + n0 + n4); LAS float* d = scr + kk * 33 + n4; d[0] = v[0]; d[1] = v[1]; d[2] = v[2]; d[3] = v[3]; }
    asm volatile("s_waitcnt lgkmcnt(0)" ::: "memory");
    const int drow0 = mode ? (256 * (n0 / 128) + (mode == 2 ? 128 : 0) + (n0 % 128)) : n0;
    const int c = lane & 7;
    f32x4 g0 = {1.f, 1.f, 1.f, 1.f}, g1 = {1.f, 1.f, 1.f, 1.f};
    if (gain) { g0 = *(const f32x4*)(gain + k0 + 8 * c); g1 = *(const f32x4*)(gain + k0 + 8 * c + 4); }
#pragma unroll
    for (int j = 0; j < 4; ++j) { const int n = (lane >> 3) + 8 * j; const LAS float* s = scr + (8 * c) * 33 + n;
        u32x4 o; o.x = pk2(s[0 * 33] * g0[0], s[1 * 33] * g0[1]); o.y = pk2(s[2 * 33] * g0[2], s[3 * 33] * g0[3]); o.z = pk2(s[4 * 33] * g1[0], s[5 * 33] * g1[1]); o.w = pk2(s[6 * 33] * g1[2], s[7 * 33] * g1[3]);
        *(u32x4*)(WT + (size_t)(drow0 + n) * K + k0 + 8 * c) = o; }
    asm volatile("s_waitcnt lgkmcnt(0)" ::: "memory");
}
DI void x_row_prep(const float* xrow, bf16* orow, float* ssqrow, int lane) {
    const f32x4* xr = (const f32x4*)xrow + lane; f32x4 v[4]; float s = 0.f;
#pragma unroll
    for (int j = 0; j < 4; ++j) { v[j] = xr[64 * j]; s += (v[j][0] * v[j][0] + v[j][1] * v[j][1]) + (v[j][2] * v[j][2] + v[j][3] * v[j][3]); }
    s = wave_sum(s);
    u32x2* o8 = (u32x2*)orow + lane;
#pragma unroll
    for (int j = 0; j < 4; ++j) { u32x2 w; w.x = pk2(v[j][0], v[j][1]); w.y = pk2(v[j][2], v[j][3]); o8[64 * j] = w; }
    if (lane < 16) ssqrow[lane] = (lane == 0) ? s : 0.f;
}
DI void tail_reduce_quarter(float* xrow, const float* prow, bf16* orow, float* ssqrow, int quarter, int lane) {
    f32x4* xr = (f32x4*)xrow + quarter * 64 + lane; f32x4 v = *xr; f32x4 p[11];
#pragma unroll
    for (int ks = 0; ks < 11; ++ks) p[ks] = *((const f32x4*)(prow + (size_t)ks * 1024 * 1024) + quarter * 64 + lane);
#pragma unroll
    for (int ks = 0; ks < 11; ++ks) v = v + p[ks];
    *xr = v;
    const float s = wave_sum((v[0] * v[0] + v[1] * v[1]) + (v[2] * v[2] + v[3] * v[3]));
    u32x2 w; w.x = pk2(v[0], v[1]); w.y = pk2(v[2], v[3]); *((u32x2*)orow + quarter * 64 + lane) = w;
    if (lane == 0) ssqrow[quarter] = s;
    if (quarter == 0 && lane >= 4 && lane < 16) ssqrow[lane] = 0.f;
}
DI void p0_prologue(const Args& a, ldsp lds, int gw, int ngw, int wave, int lane) {
    LAS float* scr = (LAS float*)(lds + wave * 16384);
    unsigned char* ws = a.ws;
    const float* norm_g = a.in[7];
    constexpr int I_GU = 16 * 88, I_D = 44 * 32, I_EI = 16 * 52, I_EO = 22 * 32, I_OI = 16 * 120, I_OO = 22 * 32;
    constexpr int NITEMS = 8 * I_GU + 4 * I_D + I_EI + I_EO + I_OI + I_OO;
#ifndef DBG_NO_TR
#ifndef DBG_TR_MAX
#define DBG_TR_MAX NITEMS
#endif
    for (int it = gw; it < DBG_TR_MAX; it += ngw) {
        int r = it;
        if (r < 8 * I_GU) { const int mat = r / (2 * I_GU), rr = r % (2 * I_GU), isup = rr / I_GU, item = rr % I_GU; const int l = mat >> 1, i = mat & 1;
            const float* W = (isup ? a.in[10] : a.in[9]) + (size_t)mat * 1024 * 2816;
            transpose_item(W, 1024, 2816, norm_g + (l * 3 + (i ? 2 : 0)) * 1024, (bf16*)(ws + WS_WGU) + (size_t)mat * WGU_STRIDE, item, lane, scr, 1 + isup); continue; }
        r -= 8 * I_GU;
        if (r < 4 * I_D) { const int mat = r / I_D, item = r % I_D; transpose_item(a.in[11] + (size_t)mat * 2816 * 1024, 2816, 1024, nullptr, (bf16*)(ws + WS_WD) + (size_t)mat * WD_STRIDE, item, lane, scr, 0); continue; }
        r -= 4 * I_D;
        if (r < I_EI) { transpose_item(a.in[12], 1024, 1664, norm_g + (0 * 3 + 1) * 1024, (bf16*)(ws + WS_WEI), r, lane, scr, 0); continue; } r -= I_EI;
        if (r < I_EO) { transpose_item(a.in[13], 1408, 1024, nullptr, (bf16*)(ws + WS_WEO), r, lane, scr, 0); continue; } r -= I_EO;
        if (r < I_OI) { transpose_item(a.in[17], 1024, 3840, norm_g + (1 * 3 + 1) * 1024, (bf16*)(ws + WS_WOI), r, lane, scr, 0); continue; } r -= I_OI;
        transpose_item(a.in[18], 1408, 1024, nullptr, (bf16*)(ws + WS_WOO), r, lane, scr, 0);
    }
#endif
    { u32x4* z = (u32x4*)((bf16*)(ws + WS_WEI) + (size_t)1664 * 1024); const u32x4 zz = {0u, 0u, 0u, 0u};
      for (int i = gw * 64 + lane; i < 128 * 1024 / 8; i += ngw * 64) z[i] = zz; }
    for (int m = gw; m < T; m += 2 * ngw) {
        const int m2 = m + ngw; const bool has2 = m2 < T;
        const float* xa = (m < TP) ? a.in[0] + (size_t)m * 1024 : a.in[1] + (size_t)(m - TP) * 1024;
        const float* xb = has2 ? ((m2 < TP) ? a.in[0] + (size_t)m2 * 1024 : a.in[1] + (size_t)(m2 - TP) * 1024) : xa;
        f32x4 va[4], vb[4];
#pragma unroll
        for (int j = 0; j < 4; ++j) { va[j] = *((const f32x4*)xa + lane + 64 * j); vb[j] = *((const f32x4*)xb + lane + 64 * j); }
#pragma unroll
        for (int h2 = 0; h2 < 2; ++h2) {
            if (h2 == 1 && !has2) break;
            const int mm = h2 ? m2 : m; float sq = 0.f;
            u32x2* o8 = (u32x2*)((bf16*)(ws + WS_XB) + (size_t)mm * 1024) + lane;
#pragma unroll
            for (int j = 0; j < 4; ++j) { const f32x4 v = h2 ? vb[j] : va[j]; sq += (v[0] * v[0] + v[1] * v[1]) + (v[2] * v[2] + v[3] * v[3]);
                u32x2 w; w.x = pk2(v[0], v[1]); w.y = pk2(v[2], v[3]); o8[64 * j] = w;
                if (mm >= TP) *((f32x4*)(a.out + O_Y + (size_t)mm * 1024) + lane + 64 * j) = v; }
            sq = wave_sum(sq);
            float* ssqrow = (float*)(ws + WS_SSQ) + (size_t)mm * 16;
            if (lane < 16) ssqrow[lane] = (lane == 0) ? sq : 0.f;
        }
    }
}
DI void final_norm(const Args& a, int gw, int ngw, int lane) {
    const float* ssq = (const float*)(a.ws + WS_SSQ); const f32x4* g4 = (const f32x4*)a.in[8] + lane;
    for (int m = gw; m < T; m += ngw) {
        const float rs = pg8::row_rstd(ssq, m); f32x4* xr = (f32x4*)(a.out + (size_t)m * 1024) + lane;
#pragma unroll
        for (int j = 0; j < 4; ++j) { const f32x4 v = xr[64 * j], g = g4[64 * j]; xr[64 * j] = v * rs * g; }
    }
}

DI void pool_item(const Args& a, ldsp lds, int item, int tid) {
    const bool samp = item >= 2048; int b, ck, g;
    if (!samp) { b = item >> 8; ck = (item >> 2) & 63; g = item & 3; } else { const int r = item - 2048; b = r >> 2; g = r & 3; ck = 0; }
    const size_t tok0 = samp ? (size_t)TP + b * 64 : (size_t)b * 4096 + ck * 64;
    const int t0 = samp ? 0 : ck * 64;
    LAS float* U = (LAS float*)lds;
    LAS float* Dd = U + 79 * 96;
    LAS float* Wp = Dd + 64 * 97;
    const bf16* E0 = (const bf16*)(a.ws + WS_E);
    const float* cpool = a.in[2];
    {   u32x4 w[2]; f32x4 c0[2], c1[2]; int kind[2];
#pragma unroll
        for (int k = 0; k < 2; ++k) { const int idx = tid + NTHR * k, i = idx / 12, ch = idx % 12, tt = t0 - 15 + i;
            kind[k] = (idx >= 79 * 12) ? 3 : (tt >= 0) ? 0 : (samp ? 1 : 2);
            if (kind[k] == 0) w[k] = *(const u32x4*)(E0 + (tok0 + i - 15) * E0W + g * 96 + ch * 8);
            else if (kind[k] == 1) { const float* cp = cpool + (size_t)(b * 15 + i) * 384 + g * 96 + ch * 8; c0[k] = *(const f32x4*)cp; c1[k] = *(const f32x4*)(cp + 4); } }
#pragma unroll
        for (int k = 0; k < 2; ++k) { const int idx = tid + NTHR * k, i = idx / 12, ch = idx % 12;
            if (kind[k] == 3) continue;
            f32x4 a0 = {0.f, 0.f, 0.f, 0.f}, a1 = {0.f, 0.f, 0.f, 0.f};
            if (kind[k] == 0) { a0 = (f32x4){bflo(w[k].x), bfhi(w[k].x), bflo(w[k].y), bfhi(w[k].y)}; a1 = (f32x4){bflo(w[k].z), bfhi(w[k].z), bflo(w[k].w), bfhi(w[k].w)}; }
            else if (kind[k] == 1) { a0 = c0[k]; a1 = c1[k]; }
            LAS float* up = U + i * 96 + ch * 8; *(LAS f32x4*)up = a0; *(LAS f32x4*)(up + 4) = a1; } }
    for (int idx = tid; idx < 96 * 96; idx += NTHR) Wp[idx] = a.in[14][g * 9216 + idx];
    __syncthreads();
    if (samp || ck == 63) { float* po = a.out + (samp ? O_POOLS : O_POOLP);
        for (int idx = tid; idx < 15 * 96; idx += NTHR) { const int i = idx / 96, c = idx % 96; po[(size_t)(b * 15 + i) * 384 + g * 96 + c] = U[(64 + i) * 96 + c]; } }
    const int w = 2 << g;
    for (int idx = tid; idx < 64 * 96; idx += NTHR) { const int t = idx / 96, c = idx % 96; float s = 0.f;
        for (int j = 0; j < w; ++j) s += U[(15 + t - j) * 96 + c];
        const int pos = (samp ? 4096 : t0) + t; const int cnt = (pos + 1 < w) ? pos + 1 : w;
        Dd[t * 97 + c] = s / (float)cnt - U[(15 + t) * 96 + c]; }
    __syncthreads();
    { const int t = tid >> 3, d0 = (tid & 7) * 12; float acc[12];
#pragma unroll
      for (int i = 0; i < 12; ++i) acc[i] = 0.f;
      for (int c = 0; c < 96; ++c) { const float dv = Dd[t * 97 + c]; const LAS f32x4* wp = (const LAS f32x4*)(Wp + c * 96 + d0);
#pragma unroll
          for (int q = 0; q < 3; ++q) { const f32x4 wv = wp[q];
#pragma unroll
              for (int i = 0; i < 4; ++i) acc[4 * q + i] += dv * wv[i]; } }
      const float* sc = a.in[15] + g * 96 + d0;
      bf16* mo = (bf16*)(a.ws + WS_MIX) + (tok0 + t) * MIX0W + g * 96 + d0;
#pragma unroll
      for (int q = 0; q < 3; ++q) { u32x2 wv; wv.x = pk2(acc[4 * q] * sc[4 * q], acc[4 * q + 1] * sc[4 * q + 1]); wv.y = pk2(acc[4 * q + 2] * sc[4 * q + 2], acc[4 * q + 3] * sc[4 * q + 3]); *(u32x2*)(mo + 4 * q) = wv; } }
    __syncthreads();
}

constexpr int SWA_VS = 192;
DI void swa_unit(const Args& a, ldsp lds, int unit, int tid) {
    const int lane = tid & 63, wave = tid >> 6, r32 = lane & 31, hi = lane >> 5;
    const bool samp = unit >= 1024; int b, c, kvh;
    if (!samp) { b = unit >> 7; c = (unit >> 1) & 63; kvh = unit & 1; } else { const int r = unit - 1024; b = r >> 1; kvh = r & 1; c = 0; }
    const size_t tok0 = samp ? (size_t)TP + b * 64 : (size_t)b * 4096 + c * 64;
    const bf16* E0 = (const bf16*)(a.ws + WS_E);
    ldsp Kb = lds, Vb = lds + 3 * 8192;
    const bool last = samp || c == 63;
    {   const int key = tid >> 3, ch = tid & 7;
#pragma unroll
        for (int j = 0; j < 3; ++j) {
            u32x4 kw, vw; f32x4 kf0, kf1, vf0, vf1; bool valid = true;
            if (samp && j < 2) { const size_t off = ((size_t)(b * 128 + 64 * j + key) * 2 + kvh) * 64 + ch * 8;
                kf0 = *(const f32x4*)(a.in[3] + off); kf1 = *(const f32x4*)(a.in[3] + off + 4); vf0 = *(const f32x4*)(a.in[4] + off); vf1 = *(const f32x4*)(a.in[4] + off + 4);
                kw = pack8(kf0, kf1); vw = pack8(vf0, vf1);
            } else { const int kc = samp ? 0 : c - 2 + j; valid = kc >= 0;
                if (valid) { const size_t row = samp ? tok0 + key : (size_t)b * 4096 + kc * 64 + key;
                    kw = *(const u32x4*)(E0 + row * E0W + 1408 + kvh * 64 + ch * 8); vw = *(const u32x4*)(E0 + row * E0W + 1536 + kvh * 64 + ch * 8);
                    kf0 = (f32x4){bflo(kw.x), bfhi(kw.x), bflo(kw.y), bfhi(kw.y)}; kf1 = (f32x4){bflo(kw.z), bfhi(kw.z), bflo(kw.w), bfhi(kw.w)};
                    vf0 = (f32x4){bflo(vw.x), bfhi(vw.x), bflo(vw.y), bfhi(vw.y)}; vf1 = (f32x4){bflo(vw.z), bfhi(vw.z), bflo(vw.w), bfhi(vw.w)}; } }
            if (valid) {
                *(LAS u32x4*)(Kb + j * 8192 + ch * 1024 + ((key ^ ch) * 16)) = kw; *(LAS u32x4*)(Vb + j * (64 * SWA_VS) + key * SWA_VS + ch * 16) = vw;
                if (last && j >= 1) { const size_t oo = ((size_t)(b * 128 + (j - 1) * 64 + key) * 2 + kvh) * 64 + ch * 8;
                    float* ko = a.out + (samp ? O_SKS : O_SKP) + oo; float* vo = a.out + (samp ? O_SVS : O_SVP) + oo;
                    *(f32x4*)ko = kf0; *(f32x4*)(ko + 4) = kf1; *(f32x4*)vo = vf0; *(f32x4*)(vo + 4) = vf1; } }
        }
    }
    __syncthreads();
    {   const int head = kvh * 8 + wave; const float sink2 = a.in[16][head] * LOG2E;
        const int j0 = samp ? 0 : (c >= 2 ? 0 : 2 - c);
        const int i16 = lane & 15;
        const int vlo = (4 * hi + (i16 >> 2)) * SWA_VS + ((lane >> 4) & 1) * 32 + (i16 & 3) * 8;
        bf16* MO = (bf16*)(a.ws + WS_MIX);
#pragma unroll 1
        for (int rb = 0; rb < 2; ++rb) {
            const size_t qrow = tok0 + rb * 32 + r32; bf16x8 q[4];
#pragma unroll
            for (int d0 = 0; d0 < 4; ++d0) q[d0] = scale_q(*(const bf16x8*)(E0 + qrow * E0W + 384 + head * 64 + d0 * 16 + hi * 8));
            float m = sink2, l = hi ? 0.f : 1.f; f32x16 o[2]; o[0] = zero16(); o[1] = zero16(); f32x16 negm;
#pragma unroll
            for (int r = 0; r < 16; ++r) negm[r] = -sink2;
            for (int j = j0; j < 3; ++j) attn_tile<2, SWA_VS>(m, negm, l, o, Kb + j * 8192, 0, Vb + j * (64 * SWA_VS) + vlo, q, r32, hi, false);
            l += __shfl_xor(l, 32); const float inv = 1.0f / l;
#pragma unroll
            for (int db = 0; db < 2; ++db)
#pragma unroll
                for (int g = 0; g < 4; ++g) { u32x2 wv; wv.x = pk2(o[db][4 * g] * inv, o[db][4 * g + 1] * inv); wv.y = pk2(o[db][4 * g + 2] * inv, o[db][4 * g + 3] * inv);
                    *(u32x2*)(MO + qrow * MIX0W + 384 + head * 64 + 32 * db + 8 * g + 4 * hi) = wv; }
        }
    }
    __syncthreads();
}
constexpr int DF_VS = 320;
constexpr int DF_BUF = 16384 + 64 * DF_VS;
DI void diff_load(u32x4 (&kr)[2], u32x4 (&vr)[2], const Args& a, bool from_cache, size_t rowE, size_t rowC, int h, int tid) {
    const bf16* E1 = (const bf16*)(a.ws + WS_E);
#pragma unroll
    for (int i = 0; i < 2; ++i) { const int idx = tid + NTHR * i, key = idx >> 4, ch = idx & 15;
        if (!from_cache) { const bf16* p = E1 + (rowE + key) * E1W + h * 128 + ch * 8; kr[i] = *(const u32x4*)(p + 1024); vr[i] = *(const u32x4*)(p + 2048); }
        else { const size_t off = ((rowC + key) * 8 + h) * 128 + ch * 8; const float* kp = a.in[5] + off; const float* vp = a.in[6] + off;
            kr[i] = pack8(*(const f32x4*)kp, *(const f32x4*)(kp + 4)); vr[i] = pack8(*(const f32x4*)vp, *(const f32x4*)(vp + 4)); } }
}
DI void diff_store(ldsp buf, const u32x4 (&kr)[2], const u32x4 (&vr)[2], int tid) {
#pragma unroll
    for (int i = 0; i < 2; ++i) { const int idx = tid + NTHR * i, key = idx >> 4, ch = idx & 15;
        *(LAS u32x4*)(buf + ch * 1024 + ((key ^ ch) * 16)) = kr[i]; *(LAS u32x4*)(buf + 16384 + key * DF_VS + ch * 16) = vr[i]; }
}
template <bool SAMP> DI void diff_unit(const Args& a, ldsp lds, int b, int h, int qb, float lam, int tid) {
    constexpr bool samp = SAMP;
    const int lane = tid & 63, wave = tid >> 6, r32 = lane & 31, hi = lane >> 5, map = wave & 1, qblk = wave >> 1;
    const bf16* E1 = (const bf16*)(a.ws + WS_E);
    const size_t tok0 = samp ? (size_t)TP + b * 64 : (size_t)b * 4096 + 128 * qb;
    const int NT = samp ? 65 : 2 * qb + 2;
    const bool active = samp ? (wave < 4) : true;
    const int tmax = samp ? 64 : 2 * qb + (wave >> 2);
    const size_t qrow = tok0 + (active ? 32 * qblk : 0) + r32;
    bf16x8 q[4];
#pragma unroll
    for (int d0 = 0; d0 < 4; ++d0) q[d0] = scale_q(*(const bf16x8*)(E1 + qrow * E1W + h * 128 + map * 64 + d0 * 16 + hi * 8));
    float m = 0.f, l = 0.f; f32x16 o[4]; f32x16 negm = zero16();
#pragma unroll
    for (int i = 0; i < 4; ++i) o[i] = zero16();
    const int i16 = lane & 15;
    const int vlo = 16384 + (4 * hi + (i16 >> 2)) * DF_VS + ((lane >> 4) & 1) * 32 + (i16 & 3) * 8;
    if constexpr (!SAMP) {
    u32x4 krA[2], vrA[2], krB[2], vrB[2];
    const size_t seq0 = (size_t)b * 4096;
#define DLOAD(KR, VR, tt) diff_load(KR, VR, a, samp && ((tt) < 64), samp ? tok0 : seq0 + 64 * (size_t)(tt), seq0 + 64 * (size_t)(tt), h, tid)
    DLOAD(krA, vrA, 0);
    diff_store(lds, krA, vrA, tid);
    if (1 < NT) DLOAD(krA, vrA, 1);
    __syncthreads();
    int curoff = 0;
#define DSTEP(tt, LKR, LVR, SKR, SVR) do { \
        const int nxtoff = (curoff == 2 * DF_BUF) ? 0 : curoff + DF_BUF; \
        if ((tt) + 2 < NT) DLOAD(LKR, LVR, (tt) + 2); \
        if (active && (tt) <= tmax) attn_tile<4, DF_VS>(m, negm, l, o, lds + curoff, 8 * map, lds + curoff + vlo, q, r32, hi, (tt) == 0); \
        if ((tt) + 1 < NT) diff_store(lds + nxtoff, SKR, SVR, tid); \
        asm volatile("s_waitcnt lgkmcnt(0)\n\ts_barrier" ::: "memory");     \
        curoff = nxtoff; } while (0)
#pragma unroll 1
    for (int t = 0; t < NT; t += 2) {
        DSTEP(t, krB, vrB, krA, vrA);
        if (t + 1 >= NT) break;
        DSTEP(t + 1, krA, vrA, krB, vrB);
    }
#undef DSTEP
    __syncthreads();
#undef DLOAD
    } else {
    u32x4 kr[2], vr[2];
    const size_t seq0 = (size_t)b * 4096;
    diff_load(kr, vr, a, samp, samp ? tok0 : seq0, seq0, h, tid);
    diff_store(lds, kr, vr, tid);
    __syncthreads();
#pragma unroll 1
    for (int t = 0; t < NT; ++t) {
        cldsp cur = lds + (t & 1) * DF_BUF;
        if (t + 1 < NT) diff_load(kr, vr, a, samp && (t + 1 < 64), samp ? tok0 : seq0 + 64 * (t + 1), seq0 + 64 * (t + 1), h, tid);
        if (active && t <= tmax) attn_tile<4, DF_VS>(m, negm, l, o, cur, 8 * map, cur + vlo, q, r32, hi, t == 0);
        if (t + 1 < NT) diff_store(lds + ((t + 1) & 1) * DF_BUF, kr, vr, tid);
        __syncthreads();
    }
    }
    l += __shfl_xor(l, 32);
    LAS float* xch = (LAS float*)lds + qblk * 4096 + lane;
    if (active && map == 1) { const float sc = lam / l;
#pragma unroll
        for (int db = 0; db < 4; ++db)
#pragma unroll
            for (int r = 0; r < 16; ++r) xch[(db * 16 + r) * 64] = o[db][r] * sc; }
    __syncthreads();
    if (active && map == 0) {
        const float i1 = 1.0f / l; float ss = 0.f;
#pragma unroll
        for (int db = 0; db < 4; ++db)
#pragma unroll
            for (int r = 0; r < 16; ++r) { const float v = o[db][r] * i1 - xch[(db * 16 + r) * 64]; o[db][r] = v; ss += v * v; }
        ss += __shfl_xor(ss, 32);
        const float lam_init = 0.8f - 0.6f * 0.74081822068171786f;
        const float rn = (1.0f / sqrtf(ss * (1.0f / 128.0f) + 1e-6f)) * (1.0f - lam_init);
        bf16* MO = (bf16*)(a.ws + WS_MIX) + qrow * MIX1W + h * 128;
        const float* sg = a.in[20];
#pragma unroll
        for (int db = 0; db < 4; ++db)
#pragma unroll
            for (int g = 0; g < 4; ++g) { const int d = 32 * db + 8 * g + 4 * hi; const f32x4 gg = *(const f32x4*)(sg + d);
                u32x2 wv; wv.x = pk2(o[db][4 * g] * rn * gg[0], o[db][4 * g + 1] * rn * gg[1]); wv.y = pk2(o[db][4 * g + 2] * rn * gg[2], o[db][4 * g + 3] * rn * gg[3]);
                *(u32x2*)(MO + d) = wv; }
    }
    __syncthreads();
}

DI void gmlp_item(const Args& a, ldsp lds, int item, int tid) {
    const int lane = tid & 63, wave = tid >> 6;
    const int ci = item >> 2, g = item & 3; const bool samp = ci >= 256;
    const int b = samp ? ci - 256 : ci >> 5; const int LC = samp ? 64 : 128;
    const size_t tok0 = samp ? (size_t)TP + b * 64 : (size_t)b * 4096 + (ci & 31) * 128;
    const bf16* E1 = (const bf16*)(a.ws + WS_E);
    LAS float* Wl = (LAS float*)lds;
    LAS float* VG = Wl + 128 * 132;
    const float* Wg = a.in[23] + (size_t)g * 128 * 128;
    {   f32x4 wr8[8];
#pragma unroll
        for (int k = 0; k < 8; ++k) { const int idx = tid + NTHR * k; wr8[k] = (f32x4){0.f, 0.f, 0.f, 0.f}; if (idx < LC * 32) wr8[k] = *((const f32x4*)Wg + idx); }
#pragma unroll
        for (int k = 0; k < 8; ++k) { const int idx = tid + NTHR * k, t = idx >> 5, s4 = (idx & 31) * 4;
            if (idx < LC * 32) { f32x4 v = wr8[k]; v[0] = (s4 <= t) ? v[0] : 0.f; v[1] = (s4 + 1 <= t) ? v[1] : 0.f; v[2] = (s4 + 2 <= t) ? v[2] : 0.f; v[3] = (s4 + 3 <= t) ? v[3] : 0.f;
                *(LAS f32x4*)(Wl + t * 132 + s4) = v; } } }
    for (int rb = 0; rb < LC / NWAVES; rb += 8) {
        u32x4 wv8[8];
#pragma unroll
        for (int k = 0; k < 8; ++k) { const int row = wave + NWAVES * (rb + k); wv8[k] = (u32x4){0u, 0u, 0u, 0u};
            if (lane < 48) wv8[k] = *(const u32x4*)(E1 + (tok0 + row) * E1W + 3456 + lane * 8); }
#pragma unroll
        for (int k = 0; k < 8; ++k) { const int row = wave + NWAVES * (rb + k); const u32x4 w = wv8[k];
            float x[8]; float s = 0.f;
            x[0] = bflo(w.x); x[1] = bfhi(w.x); x[2] = bflo(w.y); x[3] = bfhi(w.y); x[4] = bflo(w.z); x[5] = bfhi(w.z); x[6] = bflo(w.w); x[7] = bfhi(w.w);
#pragma unroll
            for (int i = 0; i < 8; ++i) { x[i] = (lane < 48) ? gelu_erf(x[i]) : 0.f; s += x[i]; }
            const float mean = wave_sum(s) * (1.0f / 384.0f); float q = 0.f;
#pragma unroll
            for (int i = 0; i < 8; ++i) { x[i] = (lane < 48) ? x[i] - mean : 0.f; q += x[i] * x[i]; }
            const float rstd = 1.0f / sqrtf(wave_sum(q) * (1.0f / 384.0f) + 1e-6f);
            if (lane >= 12 * g && lane < 12 * g + 12) {
                const float* lg = a.in[21] + lane * 8; const float* lb = a.in[22] + lane * 8;
                float y[8];
#pragma unroll
                for (int i = 0; i < 8; ++i) y[i] = x[i] * rstd * lg[i] + lb[i];
                LAS float* vo = VG + row * 96 + (lane - 12 * g) * 8;
                *(LAS f32x4*)vo = (f32x4){y[0], y[1], y[2], y[3]}; *(LAS f32x4*)(vo + 4) = (f32x4){y[4], y[5], y[6], y[7]};
                if (samp) { float* go = a.out + O_GV + ((size_t)(b * 64 + row) * 384 + lane * 8); *(f32x4*)go = (f32x4){y[0], y[1], y[2], y[3]}; *(f32x4*)(go + 4) = (f32x4){y[4], y[5], y[6], y[7]}; }
            }
        }
    }
    __syncthreads();
    {   const int tq = tid >> 4, cq = tid & 15;
        if (tq * 4 < LC) {
            float acc[4][6];
#pragma unroll
            for (int i = 0; i < 4; ++i)
#pragma unroll
                for (int j = 0; j < 6; ++j) acc[i][j] = 0.f;
            for (int sc = 0; sc <= tq; ++sc) {
                f32x4 wv[4];
#pragma unroll
                for (int i = 0; i < 4; ++i) wv[i] = *(const LAS f32x4*)(Wl + (4 * tq + i) * 132 + 4 * sc);
#pragma unroll
                for (int k = 0; k < 4; ++k) { const LAS float* vp = VG + (4 * sc + k) * 96 + 6 * cq; float v[6];
#pragma unroll
                    for (int j = 0; j < 6; ++j) v[j] = vp[j];
#pragma unroll
                    for (int i = 0; i < 4; ++i)
#pragma unroll
                        for (int j = 0; j < 6; ++j) acc[i][j] += wv[i][k] * v[j]; }
            }
            bf16* MO = (bf16*)(a.ws + WS_MIX);
#pragma unroll
            for (int i = 0; i < 4; ++i) { const int t = 4 * tq + i; const float bias = a.in[24][g * 128 + t]; const size_t tok = tok0 + t;
                const unsigned* up = (const unsigned*)(E1 + tok * E1W + 3072 + g * 96 + 6 * cq); unsigned* op = (unsigned*)(MO + tok * MIX1W + 1024 + g * 96 + 6 * cq);
#pragma unroll
                for (int j = 0; j < 3; ++j) { const unsigned w = up[j]; op[j] = pk2(gelu_erf(bflo(w)) * (acc[i][2 * j] + bias), gelu_erf(bfhi(w)) * (acc[i][2 * j + 1] + bias)); } }
        }
    }
    __syncthreads();
}

#define XB_TMO      128
#define XB_XCNT(j)  (256  + 64 * (j))
#define XB_XSUB(j)  (1280 + 64 * (j))
#define XB_XGEN(j)  (2304 + 64 * (j))
#define XB_TOP      3328
#define XB_TOPGEN   3392
#define XCD_BAR_WORDS 3456
#define XB_SPIN_CAP (1u << 18)

__device__ __forceinline__ unsigned xb_ld(unsigned* p)              { return __hip_atomic_load(p, __ATOMIC_RELAXED, __HIP_MEMORY_SCOPE_AGENT); }
__device__ __forceinline__ unsigned xb_add(unsigned* p, unsigned v) { return __hip_atomic_fetch_add(p, v, __ATOMIC_RELAXED, __HIP_MEMORY_SCOPE_AGENT); }
__device__ __forceinline__ unsigned xb_xcc_id() { return (unsigned)__builtin_amdgcn_s_getreg((3 << 11) | 20) & 0xFu; }
#define XB_SPIN(cond, bar) do { unsigned _sp = 0; while (cond) { __builtin_amdgcn_s_sleep(1); \
    if ((++_sp & 255u) == 0u) { if (xb_ld(&(bar)[XB_TMO])) break; if (_sp > XB_SPIN_CAP) { atomicAdd(&(bar)[XB_TMO], 1u); break; } } } } while (0)

struct XcdBarrier {
    unsigned* bar; unsigned x;
    volatile LAS unsigned* st;
};

__device__ __forceinline__ XcdBarrier xcd_barrier_post(unsigned* bar, volatile LAS unsigned* st) {
    XcdBarrier b; b.bar = bar; b.x = xb_xcc_id(); b.st = st;
    if (threadIdx.x == 0) (void)xb_add(&bar[XB_XCNT(b.x)], 1u);
    return b;
}
__device__ __forceinline__ void xcd_barrier_complete(unsigned* bar, unsigned x, unsigned& nloc, unsigned& nx) {
    const unsigned G = gridDim.x * gridDim.y * gridDim.z;
    unsigned sum, cnt, mine, sp = 0u;
    for (;;) {
        sum = 0u; cnt = 0u; mine = 0u;
#pragma unroll
        for (unsigned j = 0; j < 16; ++j) { const unsigned c = xb_ld(&bar[XB_XCNT(j)]); sum += c; cnt += (c > 0u) ? 1u : 0u; mine = (j == x) ? c : mine; }
        if (sum == G) break;
        __builtin_amdgcn_s_sleep(1);
        if ((++sp & 255u) == 0u) { if (xb_ld(&bar[XB_TMO])) break; if (sp > XB_SPIN_CAP) { atomicAdd(&bar[XB_TMO], 1u); break; } }
    }
    nloc = mine > 0u ? mine : 1u; nx = cnt > 0u ? cnt : 1u;
}

__device__ __forceinline__ void xcd_barrier(const XcdBarrier& b) {
    asm volatile("s_waitcnt vmcnt(0)" ::: "memory");
    __syncthreads();
    if (threadIdx.x == 0) {
        unsigned* bar = b.bar;
        __builtin_amdgcn_s_waitcnt(0);
        unsigned nloc = b.st[0], nx = b.st[1];
        if (nloc == 0u) { xcd_barrier_complete(bar, b.x, nloc, nx); b.st[0] = nloc; b.st[1] = nx; }
        const unsigned old = xb_add(&bar[XB_XSUB(b.x)], 1u);
        const unsigned gen = old / nloc;
        if (old + 1u == (gen + 1u) * nloc) {
            __builtin_amdgcn_fence(__ATOMIC_RELEASE, "agent");
            asm volatile("s_waitcnt vmcnt(0)" ::: "memory");
            const unsigned og = xb_add(&bar[XB_TOP], 1u);
            const unsigned tg = og / nx;
            if (og + 1u == (tg + 1u) * nx) xb_add(&bar[XB_TOPGEN], 1u);
            else XB_SPIN(xb_ld(&bar[XB_TOPGEN]) == tg, bar);
            __builtin_amdgcn_fence(__ATOMIC_ACQUIRE, "agent");
            xb_add(&bar[XB_XGEN(b.x)], 1u);
            asm volatile("s_waitcnt vmcnt(0)" ::: "memory");
        } else {
            XB_SPIN(xb_ld(&bar[XB_XGEN(b.x)]) == gen, bar);
            __builtin_amdgcn_fence(__ATOMIC_ACQUIRE, "agent");
            asm volatile("s_waitcnt vmcnt(0)" ::: "memory");
        }
    }
    __syncthreads();
}

constexpr int GM_RS = 272;
constexpr int GV_RS = 832;
DI void gmlp_chunk(const Args& a, ldsp lds, int ci, int tid) {
    const int lane = tid & 63, wave = tid >> 6, r32 = lane & 31, hi = lane >> 5;
    const bool samp = ci >= 256; const int b = samp ? ci - 256 : ci >> 5; const int LC = samp ? 64 : 128;
    const size_t tok0 = samp ? (size_t)TP + b * 64 : (size_t)b * 4096 + (ci & 31) * 128;
    const bf16* E1 = (const bf16*)(a.ws + WS_E);
    ldsp VG = lds;
    ldsp Wl = lds + 128 * GV_RS;
    for (int rb = 0; rb < LC / NWAVES; rb += 8) {
        u32x4 wv8[8];
#pragma unroll
        for (int k = 0; k < 8; ++k) { const int row = wave + NWAVES * (rb + k); wv8[k] = (u32x4){0u, 0u, 0u, 0u};
            if (lane < 48) wv8[k] = *(const u32x4*)(E1 + (tok0 + row) * E1W + 3456 + lane * 8); }
#pragma unroll
        for (int k = 0; k < 8; ++k) { const int row = wave + NWAVES * (rb + k); const u32x4 w = wv8[k];
            float x[8]; float s = 0.f;
            x[0] = bflo(w.x); x[1] = bfhi(w.x); x[2] = bflo(w.y); x[3] = bfhi(w.y); x[4] = bflo(w.z); x[5] = bfhi(w.z); x[6] = bflo(w.w); x[7] = bfhi(w.w);
#pragma unroll
            for (int i = 0; i < 8; ++i) { x[i] = (lane < 48) ? gelu_erf(x[i]) : 0.f; s += x[i]; }
            const float mean = wave_sum(s) * (1.0f / 384.0f); float q = 0.f;
#pragma unroll
            for (int i = 0; i < 8; ++i) { x[i] = (lane < 48) ? x[i] - mean : 0.f; q += x[i] * x[i]; }
            const float rstd = 1.0f / sqrtf(wave_sum(q) * (1.0f / 384.0f) + 1e-6f);
            if (lane < 48) {
                const float* lg = a.in[21] + lane * 8; const float* lb = a.in[22] + lane * 8;
                float y[8];
#pragma unroll
                for (int i = 0; i < 8; ++i) y[i] = x[i] * rstd * lg[i] + lb[i];
                *(LAS u32x4*)(VG + row * GV_RS + lane * 16) = pack8((f32x4){y[0], y[1], y[2], y[3]}, (f32x4){y[4], y[5], y[6], y[7]});
                if (samp) { float* go = a.out + O_GV + ((size_t)(b * 64 + row) * 384 + lane * 8); *(f32x4*)go = (f32x4){y[0], y[1], y[2], y[3]}; *(f32x4*)(go + 4) = (f32x4){y[4], y[5], y[6], y[7]}; }
            }
        }
    }
    bf16* MO = (bf16*)(a.ws + WS_MIX);
#pragma unroll 1
    for (int g = 0; g < 4; ++g) {
        {   const float* Wg = a.in[23] + (size_t)g * 128 * 128; f32x4 wr8[8];
#pragma unroll
            for (int k = 0; k < 8; ++k) { const int idx = tid + NTHR * k; wr8[k] = (f32x4){0.f, 0.f, 0.f, 0.f}; if (idx < LC * 32) wr8[k] = *((const f32x4*)Wg + idx); }
#pragma unroll
            for (int k = 0; k < 8; ++k) { const int idx = tid + NTHR * k, t = idx >> 5, s4 = (idx & 31) * 4;
                if (idx < LC * 32) { const f32x4 v = wr8[k]; u32x2 pw;
                    pw.x = pk2((s4 <= t) ? v[0] : 0.f, (s4 + 1 <= t) ? v[1] : 0.f); pw.y = pk2((s4 + 2 <= t) ? v[2] : 0.f, (s4 + 3 <= t) ? v[3] : 0.f);
                    *(LAS u32x2*)(Wl + t * GM_RS + s4 * 2) = pw; } } }
        __syncthreads();
        if (wave < 6) {
            const int cb = wave % 3;
#pragma unroll 1
            for (int pass = 0; pass < 2; ++pass) {
                const int tb = (wave < 3) ? (pass ? 0 : 3) : (pass ? 1 : 2);
                if (tb * 32 < LC) {
                    f32x16 acc = zero16();
                    const int i16 = lane & 15;
                    cldsp ap = Wl + (32 * tb + r32) * GM_RS + 8 * hi;
                    cldsp bp = VG + (4 * hi + (i16 >> 2)) * GV_RS + (96 * g + 32 * cb) * 2 + ((lane >> 4) & 1) * 32 + (i16 & 3) * 8;
                    for (int ks = 0; ks < 2 * tb + 2; ++ks) {
                        const v4i16_t alo = *(const LAS v4i16_t*)(ap + 32 * ks), ahi = *(const LAS v4i16_t*)(ap + 32 * ks + 16);
                        const v4i16_t blo = vtr(bp + (16 * ks) * GV_RS), bhi = vtr(bp + (16 * ks + 8) * GV_RS);
                        acc = MFMA32(__builtin_shufflevector(alo, ahi, 0, 1, 2, 3, 4, 5, 6, 7), __builtin_shufflevector(blo, bhi, 0, 1, 2, 3, 4, 5, 6, 7), acc);
                    }
                    const int col = g * 96 + 32 * cb + r32;
#pragma unroll
                    for (int r = 0; r < 16; ++r) { const int t = 32 * tb + (r & 3) + 8 * (r >> 2) + 4 * hi; const size_t tok = tok0 + t;
                        const float u = bf2f(E1[tok * E1W + 3072 + col]);
                        MO[tok * MIX1W + 1024 + col] = (bf16)f2bf(gelu_erf(u) * (acc[r] + a.in[24][g * 128 + t])); }
                }
            }
        }
        __syncthreads();
    }
}

template <class Epi> DI void run_gemm(ldsp lds, const bf16* A, const bf16* Bt, int N, int K, const Epi& E, int M = T) {
    pg8::Gemm g{A, Bt, M, N, K, K}; pg8::StaticOrder S; S.init(M, N, (int)gridDim.x, (int)blockIdx.x);
    pg8::gemm_phase<Epi, pg8::StaticOrder, true, true>(lds, g, S, E);
}
DI void run_res_gemm(const XcdBarrier& xbar, ldsp lds, const bf16* A, const bf16* Bt, int K, const float* base, float* X, bf16* XB, float* SSQ, float* P, float alpha, int ngw) {
    { pg8::EpiRes E{base, X, XB, SSQ, alpha}; run_gemm(lds, A, Bt, 1024, K, E, TP); }
    { int ksub = K / 11; asm volatile("" : "+s"(ksub));
      pg8::Gemm g{A, Bt, T, 1024, ksub, K}; pg8::TailOrder S; S.init(ksub, (int)gridDim.x, (int)blockIdx.x); pg8::EpiPart E{P, alpha, ksub * 2};
      pg8::gemm_phase<pg8::EpiPart, pg8::TailOrder, true, true>(lds, g, S, E); }
    xcd_barrier(xbar);
    { const int t2 = fresh_tid(), lane2 = t2 & 63, gw2 = (int)blockIdx.x * NWAVES + __builtin_amdgcn_readfirstlane(t2 >> 6);
      for (int it = gw2; it < 4 * TS; it += ngw) { const int m = TP + (it >> 2); tail_reduce_quarter(X + (size_t)m * 1024, P + (size_t)(m - TP) * 1024, XB + (size_t)m * 1024, SSQ + (size_t)m * 16, it & 3, lane2); } }
}
__global__ void __launch_bounds__(NTHR, 2) fwd_mega(Args args) {
    extern __shared__ __attribute__((aligned(16))) unsigned char lds_raw[];
    ldsp lds = (ldsp)lds_raw;
    cg::grid_group grid = cg::this_grid();
    for (int u = threadIdx.x; u < (LDS_BYTES - LDSCTL_OFF) / 4; u += NTHR) ((LAS unsigned*)(lds + LDSCTL_OFF))[u] = 0u;
    __syncthreads();
    const XcdBarrier xbar = xcd_barrier_post((unsigned*)args.ws + 4096, (volatile LAS unsigned*)(lds + LDSCTL_OFF + 352));
    const int G = gridDim.x, bid = blockIdx.x, ngw = G * NWAVES;
    const int lo = args.ph_lo, hi = args.ph_hi;
    unsigned char* ws = args.ws;
    bf16* XB = (bf16*)(ws + WS_XB); bf16* HB = (bf16*)(ws + WS_H); bf16* EB = (bf16*)(ws + WS_E); bf16* MB = (bf16*)(ws + WS_MIX);
    float* SSQ = (float*)(ws + WS_SSQ); float* X = args.out + O_Y; float* PART = (float*)(ws + WS_PART);
#define IN(k) (lo <= (k) && (k) < hi)
#define SEAM(k) do { if (IN(k) && IN((k) + 1)) { if ((k) == 0 && hi > 1000) grid.sync(); else xcd_barrier(xbar); } } while (0)
    #ifndef DBG_NO_P0
    if (IN(0)) { const int t2 = fresh_tid(), w2 = __builtin_amdgcn_readfirstlane(t2 >> 6); p0_prologue(args, lds, (int)blockIdx.x * NWAVES + w2, ngw, w2, t2 & 63); }
#endif
    SEAM(0);
#define FFN_PHASES(pg, mat, first) \
    if (IN(pg)) { pg8::EpiGU E{HB, SSQ}; run_gemm(lds, XB, (const bf16*)(ws + WS_WGU) + (size_t)(mat) * WGU_STRIDE, 5632, 1024, E); } SEAM(pg); \
    if (IN((pg) + 1)) { run_res_gemm(xbar, lds, HB, (const bf16*)(ws + WS_WD) + (size_t)(mat) * WD_STRIDE, 2816, (first) ? args.in[0] : X, X, XB, SSQ, PART, 0.5f, ngw); } SEAM((pg) + 1);
    FFN_PHASES(1, 0, true)
    if (IN(3)) { pg8::EpiIn E{EB, E0W, SSQ, nullptr, nullptr}; run_gemm(lds, XB, (const bf16*)(ws + WS_WEI), 1792, 1024, E); } SEAM(3);
    if (IN(4)) {
#ifndef DBG_NO_SWA
        if (G == 256) { const int v = (bid & 7) * 32 + (bid >> 3);
            for (int k = 0; k < 4; ++k) swa_unit(args, lds, 4 * v + k, fresh_tid());
            if (v < 32) swa_unit(args, lds, 1024 + v, fresh_tid());
        } else { for (int u = bid; u < 1056; u += G) swa_unit(args, lds, u, fresh_tid()); }
#endif
#ifndef DBG_NO_POOL
        for (int it = bid; it < 2112; it += G) pool_item(args, lds, it, fresh_tid());
#endif
    }
#if DBG_REP4 > 1
    grid.sync();
    if (IN(4)) {
#ifndef DBG_NO_SWA
        if (G == 256) { const int v = (bid & 7) * 32 + (bid >> 3);
            for (int k = 0; k < 4; ++k) swa_unit(args, lds, 4 * v + k, fresh_tid());
            if (v < 32) swa_unit(args, lds, 1024 + v, fresh_tid());
        } else { for (int u = bid; u < 1056; u += G) swa_unit(args, lds, u, fresh_tid()); }
#endif
#ifndef DBG_NO_POOL
        for (int it = bid; it < 2112; it += G) pool_item(args, lds, it, fresh_tid());
#endif
    }
#endif
    SEAM(4);
    if (IN(5)) { run_res_gemm(xbar, lds, MB, (const bf16*)(ws + WS_WEO), 1408, X, X, XB, SSQ, PART, 1.0f, ngw); } SEAM(5);
    FFN_PHASES(6, 1, false)
    FFN_PHASES(8, 2, false)
    if (IN(10)) { pg8::EpiIn E{EB, E1W, SSQ, args.out + O_DK, args.out + O_DV}; run_gemm(lds, XB, (const bf16*)(ws + WS_WOI), 3840, 1024, E); } SEAM(10);
    if (IN(11)) {
        const float* lp = args.in[19];
        const int lane = fresh_tid() & 63;
        const float lam = expf(wave_sum(lp[lane] * lp[64 + lane])) - expf(wave_sum(lp[128 + lane] * lp[192 + lane])) + (0.8f - 0.6f * 0.74081822068171786f);
#ifndef DBG_NO_DIFF
        for (int v0 = bid; v0 < 256; v0 += G) { const int v = (G == 256) ? (v0 & 7) * 32 + (v0 >> 3) : v0; const int bh = v >> 2, s = v & 3;
#pragma unroll 1
            for (int k = 0; k < 8; ++k) { const int qb = 8 * (k >> 1) + ((k & 1) ? 7 - s : s); diff_unit<false>(args, lds, bh >> 3, bh & 7, qb, lam, fresh_tid()); } }
        for (int u = bid; u < 128; u += G) diff_unit<true>(args, lds, u >> 3, u & 7, 0, lam, fresh_tid());
#endif
#ifndef DBG_NO_GMLP
        if (G == 256) {
            if (bid >= 128) { for (int ci = bid - 128; ci < 272; ci += 128) gmlp_chunk(args, lds, ci, fresh_tid()); }
        } else { for (int it = G - 1 - bid; it < 1088; it += G) gmlp_item(args, lds, it, fresh_tid()); }
#endif
    }
#if DBG_REP11 > 1
    grid.sync();
    if (IN(11)) {
        const float* lp = args.in[19];
        const int lane = fresh_tid() & 63;
        const float lam = expf(wave_sum(lp[lane] * lp[64 + lane])) - expf(wave_sum(lp[128 + lane] * lp[192 + lane])) + (0.8f - 0.6f * 0.74081822068171786f);
#ifndef DBG_NO_DIFF
        for (int v0 = bid; v0 < 256; v0 += G) { const int v = (G == 256) ? (v0 & 7) * 32 + (v0 >> 3) : v0; const int bh = v >> 2, s = v & 3;
#pragma unroll 1
            for (int k = 0; k < 8; ++k) { const int qb = 8 * (k >> 1) + ((k & 1) ? 7 - s : s); diff_unit<false>(args, lds, bh >> 3, bh & 7, qb, lam, fresh_tid()); } }
        for (int u = bid; u < 128; u += G) diff_unit<true>(args, lds, u >> 3, u & 7, 0, lam, fresh_tid());
#endif
#ifndef DBG_NO_GMLP
        if (G == 256) {
            if (bid >= 128) { for (int ci = bid - 128; ci < 272; ci += 128) gmlp_chunk(args, lds, ci, fresh_tid()); }
        } else { for (int it = G - 1 - bid; it < 1088; it += G) gmlp_item(args, lds, it, fresh_tid()); }
#endif
    }
#endif
    SEAM(11);
    if (IN(12)) { run_res_gemm(xbar, lds, MB, (const bf16*)(ws + WS_WOO), 1408, X, X, XB, SSQ, PART, 1.0f, ngw); } SEAM(12);
    FFN_PHASES(13, 3, false)
    if (IN(15)) { const int t2 = fresh_tid(); final_norm(args, (int)blockIdx.x * NWAVES + __builtin_amdgcn_readfirstlane(t2 >> 6), ngw, t2 & 63); }
#undef IN
#undef SEAM
}

#ifndef MK_PER_PHASE
#define MK_PER_PHASE 0
#endif
extern "C" void kernel_launch(void* const* d_in, const int* in_sizes, int n_in, void* d_out, int out_size, void* d_ws, size_t ws_size, hipStream_t stream) {
    static int grid = 0;
    if (grid == 0) {
        if (n_in != 25 || (size_t)out_size != O_END || ws_size < WS_END) { fprintf(stderr, "kernel_launch: unexpected shapes: n_in %d out %d ws %zu\n", n_in, out_size, ws_size); grid = -1; return; }
        int dev = 0, cus = 0, per_cu = 0;
        if (hipGetDevice(&dev) != hipSuccess || hipDeviceGetAttribute(&cus, hipDeviceAttributeMultiprocessorCount, dev) != hipSuccess) { grid = -1; return; }
        if (hipFuncSetAttribute((const void*)fwd_mega, hipFuncAttributeMaxDynamicSharedMemorySize, LDS_BYTES) != hipSuccess) { fprintf(stderr, "kernel_launch: hipFuncSetAttribute failed\n"); grid = -1; return; }
        if (hipOccupancyMaxActiveBlocksPerMultiprocessor(&per_cu, (const void*)fwd_mega, NTHR, LDS_BYTES) != hipSuccess || per_cu < 1) { fprintf(stderr, "kernel_launch: occupancy query says %d\n", per_cu); per_cu = 1; }
        (void)hipGetLastError();
        grid = cus * 1;
    }
    if (grid < 0) return;
    if (hipMemsetAsync(d_ws, 0, 65536, stream) != hipSuccess) { fprintf(stderr, "kernel_launch: hipMemsetAsync failed\n"); return; }
    Args a{};
    for (int i = 0; i < 25; ++i) a.in[i] = (const float*)d_in[i];
    a.out = (float*)d_out; a.ws = (unsigned char*)d_ws;
#if MK_PER_PHASE
#ifndef DBG_PH_HI
#define DBG_PH_HI 16
#endif
    for (int p = 0; p < DBG_PH_HI; ++p) { a.ph_lo = p; a.ph_hi = p + 1; hipLaunchKernelGGL(fwd_mega, dim3(grid), dim3(NTHR), LDS_BYTES, stream, a); }
#else
    a.ph_lo = 0; a.ph_hi = 16;
    void* kargs[] = {&a};
    hipError_t e = hipLaunchCooperativeKernel((const void*)fwd_mega, dim3(grid), dim3(NTHR), kargs, LDS_BYTES, stream);
    if (e != hipSuccess) fprintf(stderr, "kernel_launch: cooperative launch failed: %s (grid %d)\n", hipGetErrorString(e), grid);
#endif
}
```

```cpp
#ifndef DBG_REP11
#define DBG_REP11 1
#endif
#ifndef DBG_REP4
#define DBG_REP4 1
#endif
#include <hip/hip_runtime.h>
#include <hip/hip_cooperative_groups.h>
#include <cstdio>
#include <cstdint>
namespace cg = cooperative_groups;
namespace pg8 {
#define PG8_LAS __attribute__((address_space(3)))
typedef unsigned short bf16_t;
typedef short bf16x8 __attribute__((ext_vector_type(8)));
typedef float f32x4 __attribute__((ext_vector_type(4)));
typedef unsigned u32x4 __attribute__((ext_vector_type(4)));
constexpr int BM = 256, BK = 64, HALF = 128, HTB = HALF * BK * 2  , STAGE_BYTES = 8 * HTB, NXCD = 8, WGM = 8;

__host__ __device__ __forceinline__ int lds_byte(int r, int c) { const int st = (r >> 4) * 2 + (c >> 5), rr = r & 15, cc = c & 31, ob = rr * 64 + cc * 2; return st * 1024 + (ob ^ (((ob >> 9) & 1) << 5)); }
__host__ __device__ __forceinline__ void stage_rc(int b, int& R, int& C) { const int st = b / 1024, sb = b % 1024, swz = sb ^ (((sb >> 9) & 1) << 5); R = (st >> 1) * 16 + swz / 64; C = (st & 1) * 32 + (swz % 64) / 2; }
__host__ __device__ __forceinline__ int perm32(int rho) { const int n = rho >> 4, i = rho & 15; return 8 * (i >> 2) + 4 * n + (i & 3); }

struct Unit { int pm, pn, koff; };
struct Gemm { const bf16_t* A; const bf16_t* Bt; int M, N, K, ld; };

struct StaticOrder {
    int nM, nN, nwg, G, c;
    __host__ __device__ void init(int M, int N, int G_, int c_) { nM = M / BM; nN = N / BM; nwg = nM * nN; G = G_; c = c_; }
    __host__ __device__ bool next(int i, Unit& u) const {
        const long L = (long)i * G + c; if (L >= nwg) return false;
        int wgid = (int)L; { const int q = nwg / NXCD, r = nwg % NXCD, xcd = wgid % NXCD, off = wgid / NXCD; wgid = (xcd < r ? xcd * (q + 1) : r * (q + 1) + (xcd - r) * q) + off; }
        const int nig = WGM * nN, gid = wgid / nig, fm = gid * WGM, gsz = (nM - fm) < WGM ? (nM - fm) : WGM;
        u.pm = fm + ((wgid % nig) % gsz); u.pn = (wgid % nig) / gsz; u.koff = 0; return true;
    }
    __device__ __forceinline__ void a_ready(const Unit&) const {}
    __device__ __forceinline__ void done(const Unit&) const {}
};

struct TailOrder {
    int G, c, ksub;
    __host__ __device__ void init(int ksub_, int G_, int c_) { G = G_; c = c_; ksub = ksub_; }
    __host__ __device__ bool next(int i, Unit& u) const {
        const int L = i * G + c; if (L >= 176) return false;
        const int uid = L / 11, ks = L % 11; u.pm = 128 + (uid >> 2); u.pn = uid & 3; u.koff = ks * ksub * 2; return true;
    }
    __device__ __forceinline__ void a_ready(const Unit&) const {}
    __device__ __forceinline__ void done(const Unit&) const {}
};
__device__ __forceinline__ unsigned cvt_pk_bf16(float lo, float hi) { unsigned r; asm volatile("v_cvt_pk_bf16_f32 %0, %1, %2" : "=v"(r) : "v"(lo), "v"(hi)); return r; }
typedef float f32x2 __attribute__((ext_vector_type(2)));
__device__ __forceinline__ float row_rstd(const float* ssq, int row) {
    const f32x4* p = (const f32x4*)(ssq + (size_t)row * 16);
    const f32x4 a = p[0], b = p[1], c = p[2], d = p[3];
    const float s = (((a[0] + a[1]) + (a[2] + a[3])) + ((b[0] + b[1]) + (b[2] + b[3]))) + (((c[0] + c[1]) + (c[2] + c[3])) + ((d[0] + d[1]) + (d[2] + d[3])));
    return 1.0f / sqrtf(s * (1.0f / 1024.0f) + 1e-6f);
}
__device__ __forceinline__ float row_rstd4(const float* ssq, int row, int fq) {
    const f32x4 a = *((const f32x4*)(ssq + (size_t)row * 16) + fq);
    float s = (a[0] + a[1]) + (a[2] + a[3]);
    s += __shfl_xor(s, 16); s += __shfl_xor(s, 32);
    return 1.0f / sqrtf(s * (1.0f / 1024.0f) + 1e-6f);
}
__device__ __forceinline__ float silu_mul(float g, float up) { return (g * up) * __builtin_amdgcn_rcpf(1.0f + __builtin_amdgcn_exp2f(g * -1.4426950408889634f)); }
struct EpiGU {
    static constexpr bool PERM = true, AFTER_DRAIN = false;
    bf16_t* H; const float* ssq;
    __device__ __forceinline__ void operator()(const f32x4 (&acc)[2][2][4][2], const Unit& u, int wr, int wc, int fr, int fq) const {
        const int row0 = u.pm * BM + wr * 64 + fr, col0 = u.pn * HALF + wc * 32 + 8 * fq;
#pragma unroll
        for (int ai = 0; ai < 2; ++ai)
#pragma unroll
            for (int m = 0; m < 4; ++m) { const int row = row0 + ai * HALF + m * 16; const float rs = row_rstd4(ssq, row, fq);
                float h[8];
#pragma unroll
                for (int n = 0; n < 2; ++n)
#pragma unroll
                    for (int i = 0; i < 4; ++i) { const float g = acc[ai][0][m][n][i] * rs, up = acc[ai][1][m][n][i] * rs; h[4 * n + i] = silu_mul(g, up); }
                u32x4 w; w.x = cvt_pk_bf16(h[0], h[1]); w.y = cvt_pk_bf16(h[2], h[3]); w.z = cvt_pk_bf16(h[4], h[5]); w.w = cvt_pk_bf16(h[6], h[7]);
                *(u32x4*)(H + (size_t)row * 2816 + col0) = w; if (m & 1) asm volatile("" ::: "memory"); }
    }
};
struct EpiRes {
    static constexpr bool PERM = true, AFTER_DRAIN = false;
    const float* base; float* X; bf16_t* XB; float* ssq; float alpha;
    __device__ __forceinline__ void operator()(const f32x4 (&acc)[2][2][4][2], const Unit& u, int wr, int wc, int fr, int fq) const {
        const int row0 = u.pm * BM + wr * 64 + fr, col0 = u.pn * BM + wc * 32 + 8 * fq;
#pragma unroll
        for (int ai = 0; ai < 2; ++ai)
#pragma unroll
            for (int m = 0; m < 4; ++m) { const int row = row0 + ai * HALF + m * 16; float sq = 0.f;
#pragma unroll
                for (int bj = 0; bj < 2; ++bj) { const size_t off = (size_t)row * 1024 + col0 + bj * HALF;
                    const f32x4 b0 = *(const f32x4*)(base + off), b1 = *(const f32x4*)(base + off + 4);
                    const f32x4 x0 = b0 + acc[ai][bj][m][0] * alpha, x1 = b1 + acc[ai][bj][m][1] * alpha;
                    *(f32x4*)(X + off) = x0; *(f32x4*)(X + off + 4) = x1;
                    u32x4 w; w.x = cvt_pk_bf16(x0[0], x0[1]); w.y = cvt_pk_bf16(x0[2], x0[3]); w.z = cvt_pk_bf16(x1[0], x1[1]); w.w = cvt_pk_bf16(x1[2], x1[3]);
                    *(u32x4*)(XB + off) = w;
                    sq += ((x0[0] * x0[0] + x0[1] * x0[1]) + (x0[2] * x0[2] + x0[3] * x0[3])) + ((x1[0] * x1[0] + x1[1] * x1[1]) + (x1[2] * x1[2] + x1[3] * x1[3])); }
                sq += __shfl_xor(sq, 16); sq += __shfl_xor(sq, 32);
                if (fq == 0) ssq[(size_t)row * 16 + u.pn * 4 + wc] = sq; if (m & 1) asm volatile("" ::: "memory"); }
    }
};
struct EpiPart {
    static constexpr bool PERM = true, AFTER_DRAIN = false;
    float* P; float alpha; int ksub2;
    __device__ __forceinline__ void operator()(const f32x4 (&acc)[2][2][4][2], const Unit& u, int wr, int wc, int fr, int fq) const {
        const int ks = u.koff / ksub2;
        const int row0 = (u.pm - 128) * BM + wr * 64 + fr, col0 = u.pn * BM + wc * 32 + 8 * fq;
        float* pb = P + ((size_t)ks * 1024 + row0) * 1024 + col0;
#pragma unroll
        for (int ai = 0; ai < 2; ++ai)
#pragma unroll
            for (int m = 0; m < 4; ++m) {
#pragma unroll
                for (int bj = 0; bj < 2; ++bj) { float* pp = pb + (size_t)(ai * HALF + m * 16) * 1024 + bj * HALF;
                    *(f32x4*)pp = acc[ai][bj][m][0] * alpha; *(f32x4*)(pp + 4) = acc[ai][bj][m][1] * alpha; } }
    }
};
struct EpiIn {
    static constexpr bool PERM = true, AFTER_DRAIN = false;
    bf16_t* E; int ldc; const float* ssq; float* fk; float* fv;
    __device__ __forceinline__ void operator()(const f32x4 (&acc)[2][2][4][2], const Unit& u, int wr, int wc, int fr, int fq) const {
        const int row0 = u.pm * BM + wr * 64 + fr, col0 = u.pn * BM + wc * 32 + 8 * fq;
        float* fo = nullptr; int fcol0 = 0;
        if (fk) { if (u.pn >= 4 && u.pn < 8) { fo = fk; fcol0 = col0 - 1024; } else if (u.pn >= 8 && u.pn < 12) { fo = fv; fcol0 = col0 - 2048; } }
#pragma unroll
        for (int ai = 0; ai < 2; ++ai)
#pragma unroll
            for (int m = 0; m < 4; ++m) { const int row = row0 + ai * HALF + m * 16; const float rs = row_rstd4(ssq, row, fq);
#pragma unroll
                for (int bj = 0; bj < 2; ++bj) { const f32x4 v0 = acc[ai][bj][m][0] * rs, v1 = acc[ai][bj][m][1] * rs;
                    u32x4 w; w.x = cvt_pk_bf16(v0[0], v0[1]); w.y = cvt_pk_bf16(v0[2], v0[3]); w.z = cvt_pk_bf16(v1[0], v1[1]); w.w = cvt_pk_bf16(v1[2], v1[3]);
                    *(u32x4*)(E + (size_t)row * ldc + col0 + bj * HALF) = w;
                    if (fo) { float* fp = fo + (size_t)row * 1024 + fcol0 + bj * HALF; *(f32x4*)fp = v0; *(f32x4*)(fp + 4) = v1; } } asm volatile("" ::: "memory"); }
    }
};
template <class Epi, class Sched, bool ALIGN_EPI = false, bool SP2 = false>
__device__ __forceinline__ void gemm_phase(PG8_LAS unsigned char* lds, const Gemm g, const Sched& S, const Epi& E) {
    const int tid = threadIdx.x, wid = __builtin_amdgcn_readfirstlane(tid >> 6), lane = tid & 63, wr = wid >> 2, wc = wid & 3, fr = lane & 15, fq = lane >> 4;
    const int K = g.ld, nt = g.K / BK;
    unsigned voffA[2], voffB[2];
#pragma unroll
    for (int i = 0; i < 2; ++i) { int R, C; stage_rc(tid * 16 + i * 8192, R, C); const int Rb = Epi::PERM ? ((R & ~31) + perm32(R & 31)) : R;
        voffA[i] = (unsigned)(R * K + C) * 2u; voffB[i] = (unsigned)(Rb * K + C) * 2u; }
    const size_t kstep = (size_t)(BK * 2);
    const size_t hstep = (size_t)HALF * K * 2;
    const size_t tstep = 2 * hstep;
    const unsigned ldsw = (unsigned)wid * 1024u;
    const int aoff = lds_byte(wr * 64 + fr, fq * 8), boff = lds_byte(wc * 32 + fr, fq * 8);
#define PG8_SA(b, h) (((b) * 2 + (h)) * HTB)
#define PG8_SB(b, h) ((4 + (b) * 2 + (h)) * HTB)
#define PG8_STAGE(bufoff, gbase, voff) do { _Pragma("unroll") for (int _i = 0; _i < 2; ++_i) \
        __builtin_amdgcn_global_load_lds((const unsigned*)((const char*)(gbase) + (voff)[_i]), (PG8_LAS unsigned*)(lds + (bufoff) + ldsw + _i * 8192), 16, 0, 0); } while (0)
#define PG8_LDA(dst, b, h) do { _Pragma("unroll") for (int m = 0; m < 4; ++m) _Pragma("unroll") for (int k = 0; k < 2; ++k) dst[m][k] = *(const PG8_LAS bf16x8*)(lds + PG8_SA(b, h) + aoff + m * 2048 + k * 1024); } while (0)
#define PG8_LDB(dst, b, h) do { _Pragma("unroll") for (int n = 0; n < 2; ++n) _Pragma("unroll") for (int k = 0; k < 2; ++k) dst[n][k] = *(const PG8_LAS bf16x8*)(lds + PG8_SB(b, h) + boff + n * 2048 + k * 1024); } while (0)
#define PG8_MMA(ai, bj, At, Bt) do { __builtin_amdgcn_s_setprio(1); _Pragma("unroll") for (int m = 0; m < 4; ++m) _Pragma("unroll") for (int n = 0; n < 2; ++n) _Pragma("unroll") for (int k = 0; k < 2; ++k) \
        acc[ai][bj][m][n] = __builtin_amdgcn_mfma_f32_16x16x32_bf16(Bt[n][k], At[m][k], acc[ai][bj][m][n], 0, 0, 0); __builtin_amdgcn_s_setprio(0); } while (0)
#define PG8_WAIT_V(n) asm volatile("s_waitcnt vmcnt(" #n ")" ::: "memory")
#define PG8_WAIT_L(n) asm volatile("s_waitcnt lgkmcnt(" #n ")" ::: "memory")
#define PG8_BAR __builtin_amdgcn_s_barrier()
#define PG8_SCHED __builtin_amdgcn_sched_barrier(0)
    Unit cur, nxt; int ui = 0;
    if (!S.next(0, cur)) return;
    f32x4 acc[2][2][4][2];
#pragma unroll
    for (int a = 0; a < 2; ++a)
#pragma unroll
        for (int b = 0; b < 2; ++b)
#pragma unroll
            for (int m = 0; m < 4; ++m)
#pragma unroll
                for (int n = 0; n < 2; ++n) acc[a][b][m][n] = (f32x4){0.f, 0.f, 0.f, 0.f};
    bf16x8 At[4][2], B0[2][2], B1[2][2];
    const char* cA = (const char*)g.A + (size_t)cur.pm * tstep + cur.koff; const char* cB = (const char*)g.Bt + (size_t)cur.pn * tstep + cur.koff;
    S.a_ready(cur);
    if constexpr (SP2) {
        PG8_STAGE(PG8_SB(0, 0), cB, voffB); PG8_STAGE(PG8_SB(0, 1), cB + hstep, voffB); PG8_STAGE(PG8_SA(0, 0), cA, voffA); PG8_STAGE(PG8_SA(0, 1), cA + hstep, voffA);
        if (wr == 1) PG8_BAR;
        PG8_WAIT_V(2); PG8_BAR;
        PG8_STAGE(PG8_SB(1, 0), cB + kstep, voffB); PG8_STAGE(PG8_SA(1, 0), cA + kstep, voffA); PG8_STAGE(PG8_SB(1, 1), cB + hstep + kstep, voffB);
        PG8_WAIT_V(6); PG8_BAR;
    } else {
        PG8_STAGE(PG8_SB(0, 0), cB, voffB); PG8_STAGE(PG8_SA(0, 0), cA, voffA); PG8_STAGE(PG8_SB(0, 1), cB + hstep, voffB); PG8_STAGE(PG8_SA(0, 1), cA + hstep, voffA);
        if (wr == 1) PG8_BAR;
        PG8_WAIT_V(4); PG8_BAR;
        PG8_STAGE(PG8_SB(1, 0), cB + kstep, voffB); PG8_STAGE(PG8_SA(1, 0), cA + kstep, voffA); PG8_STAGE(PG8_SB(1, 1), cB + hstep + kstep, voffB);
        PG8_WAIT_V(6); PG8_BAR;
    }
    for (;;) {
        const bool has_next = S.next(ui + 1, nxt);
        const char* nA = has_next ? (const char*)g.A + (size_t)nxt.pm * tstep + nxt.koff : cA; const char* nB = has_next ? (const char*)g.Bt + (size_t)nxt.pn * tstep + nxt.koff : cB;
        for (int t = 0; t < nt; t += 2) {
            const bool last = (t == nt - 2);
            const char* a1 = cA + (size_t)(t + 1) * kstep;
            const char* a2 = last ? nA : cA + (size_t)(t + 2) * kstep; const char* b2 = last ? nB : cB + (size_t)(t + 2) * kstep;
            const char* a3 = a2 + kstep; const char* b3 = b2 + kstep;
            if (last && has_next) S.a_ready(nxt);
            if constexpr (SP2) {
            PG8_LDB(B0, 0, 0); PG8_LDB(B1, 0, 1); PG8_SCHED; PG8_LDA(At, 0, 0); PG8_STAGE(PG8_SA(1, 1), a1 + hstep, voffA);
            PG8_WAIT_V(8); PG8_WAIT_L(0); PG8_BAR; PG8_MMA(0, 0, At, B0); PG8_MMA(0, 1, At, B1); PG8_BAR; PG8_SCHED;
            PG8_LDA(At, 0, 1); PG8_STAGE(PG8_SB(0, 0), b2, voffB); PG8_STAGE(PG8_SB(0, 1), b2 + hstep, voffB); PG8_STAGE(PG8_SA(0, 0), a2, voffA);
            PG8_WAIT_V(8); PG8_WAIT_L(0); PG8_BAR; PG8_MMA(1, 0, At, B0); PG8_MMA(1, 1, At, B1); PG8_BAR; PG8_SCHED;
            PG8_LDB(B0, 1, 0); PG8_LDB(B1, 1, 1); PG8_SCHED; PG8_LDA(At, 1, 0); PG8_STAGE(PG8_SA(0, 1), a2 + hstep, voffA);
            PG8_WAIT_V(8); PG8_WAIT_L(0); PG8_BAR; PG8_MMA(0, 0, At, B0); PG8_MMA(0, 1, At, B1); PG8_BAR; PG8_SCHED;
            PG8_LDA(At, 1, 1); PG8_STAGE(PG8_SB(1, 0), b3, voffB); PG8_STAGE(PG8_SB(1, 1), b3 + hstep, voffB); PG8_STAGE(PG8_SA(1, 0), a3, voffA);
            PG8_WAIT_V(8); PG8_WAIT_L(0); PG8_BAR; PG8_MMA(1, 0, At, B0); PG8_MMA(1, 1, At, B1); PG8_BAR; PG8_SCHED;
            } else {
            PG8_LDB(B0, 0, 0); PG8_SCHED; PG8_LDA(At, 0, 0); PG8_STAGE(PG8_SA(1, 1), a1 + hstep, voffA);
            PG8_WAIT_L(8); PG8_BAR; PG8_WAIT_L(0); PG8_MMA(0, 0, At, B0); PG8_BAR; PG8_SCHED;
            PG8_LDB(B1, 0, 1); PG8_STAGE(PG8_SB(0, 0), b2, voffB);
            PG8_BAR; PG8_WAIT_L(0); PG8_MMA(0, 1, At, B1); PG8_BAR;
            PG8_LDA(At, 0, 1); PG8_STAGE(PG8_SA(0, 0), a2, voffA);
            PG8_BAR; PG8_WAIT_L(0); PG8_MMA(1, 0, At, B0); PG8_BAR; PG8_SCHED;
            PG8_STAGE(PG8_SB(0, 1), b2 + hstep, voffB);
            PG8_WAIT_V(6); PG8_BAR; PG8_MMA(1, 1, At, B1); PG8_BAR;
            PG8_LDB(B0, 1, 0); PG8_SCHED; PG8_LDA(At, 1, 0); PG8_STAGE(PG8_SA(0, 1), a2 + hstep, voffA);
            PG8_WAIT_L(8); PG8_BAR; PG8_WAIT_L(0); PG8_MMA(0, 0, At, B0); PG8_BAR; PG8_SCHED;
            PG8_LDB(B1, 1, 1); PG8_STAGE(PG8_SB(1, 0), b3, voffB);
            PG8_BAR; PG8_WAIT_L(0); PG8_MMA(0, 1, At, B1); PG8_BAR;
            PG8_LDA(At, 1, 1); PG8_STAGE(PG8_SA(1, 0), a3, voffA);
            PG8_BAR; PG8_WAIT_L(0); PG8_MMA(1, 0, At, B0); PG8_BAR; PG8_SCHED;
            PG8_STAGE(PG8_SB(1, 1), b3 + hstep, voffB);
            PG8_WAIT_V(6); PG8_BAR; PG8_MMA(1, 1, At, B1); PG8_BAR;
            }
        }
        if constexpr (ALIGN_EPI) { if (wr == 0) PG8_BAR; }
        if constexpr (!Epi::AFTER_DRAIN) { E(acc, cur, wr, wc, fr, fq); S.done(cur); }
        if (!has_next) break;
#pragma unroll
        for (int a = 0; a < 2; ++a)
#pragma unroll
            for (int b = 0; b < 2; ++b)
#pragma unroll
                for (int m = 0; m < 4; ++m)
#pragma unroll
                    for (int n = 0; n < 2; ++n) acc[a][b][m][n] = (f32x4){0.f, 0.f, 0.f, 0.f};
        cur = nxt; cA = nA; cB = nB; ++ui;
        if constexpr (ALIGN_EPI) { if (wr == 1) PG8_BAR; }
    }
    PG8_WAIT_V(0);
    if constexpr (!ALIGN_EPI) { if (wr == 0) PG8_BAR; }
    PG8_BAR;
    if constexpr (Epi::AFTER_DRAIN) { E.fused(acc, cur, wr, wc, fr, fq, lds, wid, lane); S.done(cur); }
#undef PG8_SA
#undef PG8_SB
#undef PG8_STAGE
#undef PG8_LDA
#undef PG8_LDB
#undef PG8_MMA
#undef PG8_WAIT_V
#undef PG8_WAIT_L
#undef PG8_BAR
#undef PG8_SCHED
}
}
#define DI __device__ __forceinline__
#define LAS __attribute__((address_space(3)))
typedef unsigned short bf16;
typedef short bf16x8 __attribute__((ext_vector_type(8)));
typedef float f32x4 __attribute__((ext_vector_type(4)));
typedef float f32x16 __attribute__((ext_vector_type(16)));
typedef unsigned u32x4 __attribute__((ext_vector_type(4)));
typedef unsigned u32x2 __attribute__((ext_vector_type(2)));
typedef short v4i16_t __attribute__((ext_vector_type(4)));
typedef LAS unsigned char* ldsp;
typedef LAS const unsigned char* cldsp;
constexpr int NWAVES = 8, NTHR = 512;
constexpr int TP = 32768, TS = 1024, T = TP + TS, DM = 1024, FF = 2816;
constexpr int E0W = 1792, E1W = 3840, MIX0W = 1408, MIX1W = 1408;
constexpr size_t O_Y = 0, O_POOLP = (size_t)T * 1024, O_POOLS = O_POOLP + 8 * 15 * 384, O_SKP = O_POOLS + 16 * 15 * 384, O_SKS = O_SKP + 8 * 128 * 128,
    O_SVP = O_SKS + 16 * 128 * 128, O_SVS = O_SVP + 8 * 128 * 128, O_DK = O_SVS + 16 * 128 * 128, O_DV = O_DK + (size_t)T * 1024, O_GV = O_DV + (size_t)T * 1024, O_END = O_GV + 16 * 64 * 384;
constexpr size_t MiB = 1u << 20;
constexpr size_t WS_WGU = 2 * MiB, WS_WD = 46 * MiB, WS_WEI = 68 * MiB, WS_WEO = 72 * MiB, WS_WOI = 75 * MiB, WS_WOO = 83 * MiB, WS_SSQ = 87 * MiB, WS_XB = 90 * MiB,
    WS_H = 156 * MiB, WS_E = 338 * MiB, WS_MIX = 586 * MiB, WS_PART = 702 * MiB, WS_END = 746 * MiB;
constexpr size_t WGU_STRIDE = (size_t)5632 * 1024, WD_STRIDE = (size_t)1024 * 2816;
static_assert(WS_WGU + 4 * WGU_STRIDE * 2 <= WS_WD && WS_WD + 4 * WD_STRIDE * 2 <= WS_WEI && WS_WEI + (size_t)1792 * 1024 * 2 <= WS_WEO && WS_WEO + (size_t)1024 * 1408 * 2 <= WS_WOI &&
              WS_WOI + (size_t)3840 * 1024 * 2 <= WS_WOO && WS_WOO + (size_t)1024 * 1792 * 2 <= WS_SSQ && WS_SSQ + (size_t)T * 16 * 4 <= WS_XB && WS_XB + (size_t)T * 1024 * 2 <= WS_H &&
              WS_H + (size_t)T * FF * 2 <= WS_E && WS_E + (size_t)T * E1W * 2 <= WS_MIX && WS_MIX + (size_t)T * MIX1W * 2 <= WS_PART && WS_PART + (size_t)11 * 1024 * 1024 * 4 <= WS_END, "workspace map");
constexpr int RING_BYTES = 131072, LDS_BYTES = 147456, LDSCTL_OFF = LDS_BYTES - 1024;
constexpr float LOG2E = 1.4426950408889634f;
constexpr float C2 = 0.125f * LOG2E;

DI unsigned f2bf(float f) { unsigned u = __builtin_bit_cast(unsigned, f); return (u + 0x7fffu + ((u >> 16) & 1u)) >> 16; }
typedef float f32x2_t __attribute__((ext_vector_type(2))); typedef __bf16 bf16x2_t __attribute__((ext_vector_type(2)));
DI unsigned pk2(float lo, float hi) { const f32x2_t v = {lo, hi}; const bf16x2_t b = __builtin_convertvector(v, bf16x2_t); return __builtin_bit_cast(unsigned, b); }
DI float bf2f(unsigned short b) { return __builtin_bit_cast(float, (unsigned)b << 16); }
DI float bflo(unsigned w) { return __builtin_bit_cast(float, w << 16); }
DI float bfhi(unsigned w) { return __builtin_bit_cast(float, w & 0xffff0000u); }
DI u32x4 pack8(f32x4 a, f32x4 b) { u32x4 w; w.x = pk2(a[0], a[1]); w.y = pk2(a[2], a[3]); w.z = pk2(b[0], b[1]); w.w = pk2(b[2], b[3]); return w; }
DI int fresh_tid() { int t = threadIdx.x; asm volatile("" : "+v"(t)); return t; }
DI float max3f(float a, float b, float c) { float r; asm("v_max3_f32 %0, %1, %2, %3" : "=v"(r) : "v"(a), "v"(b), "v"(c)); return r; }
DI float max2f(float a, float b) { float r; asm("v_max_f32_e32 %0, %1, %2" : "=v"(r) : "v"(a), "v"(b)); return r; }
DI bf16x8 scale_q(bf16x8 v) {
    const u32x4 w = __builtin_bit_cast(u32x4, v); u32x4 r;
    r.x = pk2(bflo(w.x) * C2, bfhi(w.x) * C2); r.y = pk2(bflo(w.y) * C2, bfhi(w.y) * C2); r.z = pk2(bflo(w.z) * C2, bfhi(w.z) * C2); r.w = pk2(bflo(w.w) * C2, bfhi(w.w) * C2);
    return __builtin_bit_cast(bf16x8, r);
}
DI float wave_sum(float v) {
#pragma unroll
    for (int o = 1; o < 64; o <<= 1) v += __shfl_xor(v, o);
    return v;
}
DI float gelu_erf(float v) {
    const float av = fabsf(v), t = __builtin_amdgcn_rcpf(av * 0.2316418882f + 1.0f);
    float q = t * 0.5307027145f + (-0.7265760135f); q = q * t + 0.7107068705f; q = q * t + (-0.142248368f); q = q * t + 0.127414796f; q = q * t;
    const float e = __builtin_amdgcn_exp2f((v * v) * (-0.72134752044f));
    const float m = v * (q * e);
    return v < 0.f ? m : v - m;
}
#define MFMA32(a, b, c) __builtin_amdgcn_mfma_f32_32x32x16_bf16((a), (b), (c), 0, 0, 0)
DI f32x16 zero16() { f32x16 z; for (int i = 0; i < 16; ++i) z[i] = 0.f; return z; }
DI v4i16_t vtr(cldsp p) { return __builtin_amdgcn_ds_read_tr16_b64_v4i16((LAS v4i16_t*)p); }

struct Args { const float* in[25]; float* out; unsigned char* ws; int ph_lo, ph_hi; };

template <int NDB, int VSTR>
DI void attn_tile(float& m, f32x16& negm, float& l, f32x16 (&o)[NDB], cldsp Kt, int cb, cldsp Vlane, const bf16x8 (&q)[4], int r32, int hi, bool first) {
    f32x16 p0, p1;
#pragma unroll
    for (int hf = 0; hf < 2; ++hf) {
        bf16x8 kf[4];
#pragma unroll
        for (int dd = 0; dd < 2; ++dd) { const int d0 = 2 * hf + dd;
            const int chk = cb + 2 * d0 + hi;
            kf[2 * dd] = *(const LAS bf16x8*)(Kt + chk * 1024 + ((r32 ^ (chk & 15)) * 16));
            kf[2 * dd + 1] = *(const LAS bf16x8*)(Kt + chk * 1024 + (((32 + r32) ^ (chk & 15)) * 16)); }
#pragma unroll
        for (int dd = 0; dd < 2; ++dd) { if (hf == 0 && dd == 0) { p0 = MFMA32(kf[0], q[0], negm); p1 = MFMA32(kf[1], q[0], negm); } else { p0 = MFMA32(kf[2 * dd], q[2 * hf + dd], p0); p1 = MFMA32(kf[2 * dd + 1], q[2 * hf + dd], p1); } }
    }
    v4i16_t vf[2][4][2];
#pragma unroll
    for (int ks = 0; ks < 4; ++ks) { vf[0][ks][0] = vtr(Vlane + (16 * ks) * VSTR); vf[0][ks][1] = vtr(Vlane + (16 * ks + 8) * VSTR); }
    __builtin_amdgcn_sched_barrier(0);
    asm volatile("s_nop 15\n\ts_nop 7" : "+v"(p0), "+v"(p1));
    float mx;
    { float a = max3f(p0[0], p0[1], p1[0]), b = max3f(p0[2], p0[3], p1[1]); a = max3f(a, p1[2], p1[3]);
#pragma unroll
      for (int r = 4; r < 16; r += 4) { a = max3f(a, p0[r], p0[r + 1]); b = max3f(b, p0[r + 2], p0[r + 3]); a = max3f(a, p1[r], p1[r + 1]); b = max3f(b, p1[r + 2], p1[r + 3]); }
      mx = max2f(a, b); }
    { const auto rr = __builtin_amdgcn_permlane32_swap(__float_as_uint(mx), __float_as_uint(mx), false, false); mx = fmaxf(__uint_as_float(rr[0]), __uint_as_float(rr[1])); }
    if (first || __any(mx > 8.0f)) {
        const float delta = first ? mx : fmaxf(mx, 0.f);
        m += delta;
#pragma unroll
        for (int r = 0; r < 16; ++r) { p0[r] -= delta; p1[r] -= delta; }
        if (!first) { const float alpha = __builtin_amdgcn_exp2f(-delta); l *= alpha;
#pragma unroll
            for (int db = 0; db < NDB; ++db) o[db] = o[db] * alpha; }
#pragma unroll
        for (int r = 0; r < 16; ++r) negm[r] = -m;
    }
    float rs = 0.f;
#pragma unroll
    for (int r = 0; r < 16; ++r) { p0[r] = __builtin_amdgcn_exp2f(p0[r]); p1[r] = __builtin_amdgcn_exp2f(p1[r]); rs += p0[r] + p1[r]; }
    l += rs;
    bf16x8 pb[4];
#pragma unroll
    for (int s = 0; s < 2; ++s) {
        u32x4 w0, w1;
        w0.x = pk2(p0[8 * s + 0], p0[8 * s + 1]); w0.y = pk2(p0[8 * s + 2], p0[8 * s + 3]); w0.z = pk2(p0[8 * s + 4], p0[8 * s + 5]); w0.w = pk2(p0[8 * s + 6], p0[8 * s + 7]);
        w1.x = pk2(p1[8 * s + 0], p1[8 * s + 1]); w1.y = pk2(p1[8 * s + 2], p1[8 * s + 3]); w1.z = pk2(p1[8 * s + 4], p1[8 * s + 5]); w1.w = pk2(p1[8 * s + 6], p1[8 * s + 7]);
        pb[s] = __builtin_bit_cast(bf16x8, w0); pb[2 + s] = __builtin_bit_cast(bf16x8, w1);
    }
    __builtin_amdgcn_sched_barrier(0);
#pragma unroll
    for (int db = 0; db < NDB; ++db) {
        if (db + 1 < NDB) {
#pragma unroll
            for (int ks = 0; ks < 4; ++ks) { vf[(db + 1) & 1][ks][0] = vtr(Vlane + (16 * ks) * VSTR + (db + 1) * 64); vf[(db + 1) & 1][ks][1] = vtr(Vlane + (16 * ks + 8) * VSTR + (db + 1) * 64); }
        }
#pragma unroll
        for (int ks = 0; ks < 4; ++ks) {
            const bf16x8 a = __builtin_shufflevector(vf[db & 1][ks][0], vf[db & 1][ks][1], 0, 1, 2, 3, 4, 5, 6, 7);
            o[db] = MFMA32(a, pb[ks], o[db]);
        }
        __builtin_amdgcn_sched_barrier(0);
    }
}
template <int NDB>
DI void qk_part(float& m, f32x16& negm, float& l, f32x16 (&o)[NDB], bf16x8 (&pb)[4], cldsp Kt, int cb, const bf16x8 (&q)[4], int r32, int hi, bool first) {
    f32x16 p0, p1;
#pragma unroll
    for (int hf = 0; hf < 2; ++hf) {
        bf16x8 kf[4];
#pragma unroll
        for (int dd = 0; dd < 2; ++dd) { const int d0 = 2 * hf + dd; const int chk = cb + 2 * d0 + hi;
            kf[2 * dd] = *(const LAS bf16x8*)(Kt + chk * 1024 + ((r32 ^ (chk & 15)) * 16));
            kf[2 * dd + 1] = *(const LAS bf16x8*)(Kt + chk * 1024 + (((32 + r32) ^ (chk & 15)) * 16)); }
#pragma unroll
        for (int dd = 0; dd < 2; ++dd) { if (hf == 0 && dd == 0) { p0 = MFMA32(kf[0], q[0], negm); p1 = MFMA32(kf[1], q[0], negm); } else { p0 = MFMA32(kf[2 * dd], q[2 * hf + dd], p0); p1 = MFMA32(kf[2 * dd + 1], q[2 * hf + dd], p1); } }
    }
    float mx = fmaxf(p0[0], p1[0]);
#pragma unroll
    for (int r = 1; r < 16; ++r) mx = fmaxf(mx, fmaxf(p0[r], p1[r]));
    { const auto rr = __builtin_amdgcn_permlane32_swap(__float_as_uint(mx), __float_as_uint(mx), false, false); mx = fmaxf(__uint_as_float(rr[0]), __uint_as_float(rr[1])); }
    if (first || __any(mx > 8.0f)) {
        const float delta = first ? mx : fmaxf(mx, 0.f);
        m += delta;
#pragma unroll
        for (int r = 0; r < 16; ++r) { p0[r] -= delta; p1[r] -= delta; }
        if (!first) { const float alpha = __builtin_amdgcn_exp2f(-delta); l *= alpha;
#pragma unroll
            for (int db = 0; db < NDB; ++db) o[db] = o[db] * alpha; }
#pragma unroll
        for (int r = 0; r < 16; ++r) negm[r] = -m;
    }
    float rs = 0.f;
#pragma unroll
    for (int r = 0; r < 16; ++r) { p0[r] = __builtin_amdgcn_exp2f(p0[r]); p1[r] = __builtin_amdgcn_exp2f(p1[r]); rs += p0[r] + p1[r]; }
    l += rs;
#pragma unroll
    for (int s = 0; s < 2; ++s) {
        u32x4 w0, w1;
        w0.x = pk2(p0[8 * s + 0], p0[8 * s + 1]); w0.y = pk2(p0[8 * s + 2], p0[8 * s + 3]); w0.z = pk2(p0[8 * s + 4], p0[8 * s + 5]); w0.w = pk2(p0[8 * s + 6], p0[8 * s + 7]);
        w1.x = pk2(p1[8 * s + 0], p1[8 * s + 1]); w1.y = pk2(p1[8 * s + 2], p1[8 * s + 3]); w1.z = pk2(p1[8 * s + 4], p1[8 * s + 5]); w1.w = pk2(p1[8 * s + 6], p1[8 * s + 7]);
        pb[s] = __builtin_bit_cast(bf16x8, w0); pb[2 + s] = __builtin_bit_cast(bf16x8, w1);
    }
}
template <int NDB, int VSTR>
DI void pv_part(f32x16 (&o)[NDB], cldsp Vlane, const bf16x8 (&pb)[4]) {
    v4i16_t vf[2][4][2];
#pragma unroll
    for (int ks = 0; ks < 4; ++ks) { vf[0][ks][0] = vtr(Vlane + (16 * ks) * VSTR); vf[0][ks][1] = vtr(Vlane + (16 * ks + 8) * VSTR); }
#pragma unroll
    for (int db = 0; db < NDB; ++db) {
        if (db + 1 < NDB) {
#pragma unroll
            for (int ks = 0; ks < 4; ++ks) { vf[(db + 1) & 1][ks][0] = vtr(Vlane + (16 * ks) * VSTR + (db + 1) * 64); vf[(db + 1) & 1][ks][1] = vtr(Vlane + (16 * ks + 8) * VSTR + (db + 1) * 64); }
        }
#pragma unroll
        for (int ks = 0; ks < 4; ++ks) {
            const bf16x8 a = __builtin_shufflevector(vf[db & 1][ks][0], vf[db & 1][ks][1], 0, 1, 2, 3, 4, 5, 6, 7);
            o[db] = MFMA32(a, pb[ks], o[db]);
        }
        __builtin_amdgcn_sched_barrier(0);
    }
}
DI void transpose_item(const float* W, int K, int N, const float* gain, bf16* WT, int item, int lane, LAS float* scr, int mode) {
    const int nblk = N / 32, kb = item / nblk, nb = item % nblk, k0 = 64 * kb, n0 = 32 * nb;
#pragma unroll
    for (int i = 0; i < 8; ++i) { const int kk = 8 * i + (lane >> 3), n4 = (lane & 7) * 4;
        const f32x4 v = *(const f32x4*)(W + (size_t)(k0 + kk) * N + n0 + n4); LAS float* d = scr + kk * 33 + n4; d[0] = v[0]; d[1] = v[1]; d[2] = v[2]; d[3] = v[3]; }
    asm volatile("s_waitcnt lgkmcnt(0)" ::: "memory");
    const int drow0 = mode ? (256 * (n0 / 128) + (mode == 2 ? 128 : 0) + (n0 % 128)) : n0;
    const int c = lane & 7;
    f32x4 g0 = {1.f, 1.f, 1.f, 1.f}, g1 = {1.f, 1.f, 1.f, 1.f};
    if (gain) { g0 = *(const f32x4*)(gain + k0 + 8 * c); g1 = *(const f32x4*)(gain + k0 + 8 * c + 4); }
#pragma unroll
    for (int j = 0; j < 4; ++j) { const int n = (lane >> 3) + 8 * j; const LAS float* s = scr + (8 * c) * 33 + n;
        u32x4 o; o.x = pk2(s[0 * 33] * g0[0], s[1 * 33] * g0[1]); o.y = pk2(s[2 * 33] * g0[2], s[3 * 33] * g0[3]); o.z = pk2(s[4 * 33] * g1[0], s[5 * 33] * g1[1]); o.w = pk2(s[6 * 33] * g1[2], s[7 * 33] * g1[3]);
        *(u32x4*)(WT + (size_t)(drow0 + n) * K + k0 + 8 * c) = o; }
    asm volatile("s_waitcnt lgkmcnt(0)" ::: "memory");
}
DI void x_row_prep(const float* xrow, bf16* orow, float* ssqrow, int lane) {
    const f32x4* xr = (const f32x4*)xrow + lane; f32x4 v[4]; float s = 0.f;
#pragma unroll
    for (int j = 0; j < 4; ++j) { v[j] = xr[64 * j]; s += (v[j][0] * v[j][0] + v[j][1] * v[j][1]) + (v[j][2] * v[j][2] + v[j][3] * v[j][3]); }
    s = wave_sum(s);
    u32x2* o8 = (u32x2*)orow + lane;
#pragma unroll
    for (int j = 0; j < 4; ++j) { u32x2 w; w.x = pk2(v[j][0], v[j][1]); w.y = pk2(v[j][2], v[j][3]); o8[64 * j] = w; }
    if (lane < 16) ssqrow[lane] = (lane == 0) ? s : 0.f;
}
DI void tail_reduce_quarter(float* xrow, const float* prow, bf16* orow, float* ssqrow, int quarter, int lane) {
    f32x4* xr = (f32x4*)xrow + quarter * 64 + lane; f32x4 v = *xr; f32x4 p[11];
#pragma unroll
    for (int ks = 0; ks < 11; ++ks) p[ks] = *((const f32x4*)(prow + (size_t)ks * 1024 * 1024) + quarter * 64 + lane);
#pragma unroll
    for (int ks = 0; ks < 11; ++ks) v = v + p[ks];
    *xr = v;
    const float s = wave_sum((v[0] * v[0] + v[1] * v[1]) + (v[2] * v[2] + v[3] * v[3]));
    u32x2 w; w.x = pk2(v[0], v[1]); w.y = pk2(v[2], v[3]); *((u32x2*)orow + quarter * 64 + lane) = w;
    if (lane == 0) ssqrow[quarter] = s;
    if (quarter == 0 && lane >= 4 && lane < 16) ssqrow[lane] = 0.f;
}
DI void p0_prologue(const Args& a, ldsp lds, int gw, int ngw, int wave, int lane) {
    LAS float* scr = (LAS float*)(lds + wave * 16384);
    unsigned char* ws = a.ws;
    const float* norm_g = a.in[7];
    constexpr int I_GU = 16 * 88, I_D = 44 * 32, I_EI = 16 * 52, I_EO = 22 * 32, I_OI = 16 * 120, I_OO = 22 * 32;
    constexpr int NITEMS = 8 * I_GU + 4 * I_D + I_EI + I_EO + I_OI + I_OO;
#ifndef DBG_NO_TR
#ifndef DBG_TR_MAX
#define DBG_TR_MAX NITEMS
#endif
    for (int it = gw; it < DBG_TR_MAX; it += ngw) {
        int r = it;
        if (r < 8 * I_GU) { const int mat = r / (2 * I_GU), rr = r % (2 * I_GU), isup = rr / I_GU, item = rr % I_GU; const int l = mat >> 1, i = mat & 1;
            const float* W = (isup ? a.in[10] : a.in[9]) + (size_t)mat * 1024 * 2816;
            transpose_item(W, 1024, 2816, norm_g + (l * 3 + (i ? 2 : 0)) * 1024, (bf16*)(ws + WS_WGU) + (size_t)mat * WGU_STRIDE, item, lane, scr, 1 + isup); continue; }
        r -= 8 * I_GU;
        if (r < 4 * I_D) { const int mat = r / I_D, item = r % I_D; transpose_item(a.in[11] + (size_t)mat * 2816 * 1024, 2816, 1024, nullptr, (bf16*)(ws + WS_WD) + (size_t)mat * WD_STRIDE, item, lane, scr, 0); continue; }
        r -= 4 * I_D;
        if (r < I_EI) { transpose_item(a.in[12], 1024, 1664, norm_g + (0 * 3 + 1) * 1024, (bf16*)(ws + WS_WEI), r, lane, scr, 0); continue; } r -= I_EI;
        if (r < I_EO) { transpose_item(a.in[13], 1408, 1024, nullptr, (bf16*)(ws + WS_WEO), r, lane, scr, 0); continue; } r -= I_EO;
        if (r < I_OI) { transpose_item(a.in[17], 1024, 3840, norm_g + (1 * 3 + 1) * 1024, (bf16*)(ws + WS_WOI), r, lane, scr, 0); continue; } r -= I_OI;
        transpose_item(a.in[18], 1408, 1024, nullptr, (bf16*)(ws + WS_WOO), r, lane, scr, 0);
    }
#endif
    { u32x4* z = (u32x4*)((bf16*)(ws + WS_WEI) + (size_t)1664 * 1024); const u32x4 zz = {0u, 0u, 0u, 0u};
      for (int i = gw * 64 + lane; i < 128 * 1024 / 8; i += ngw * 64) z[i] = zz; }
    for (int m = gw; m < T; m += ngw) {
        const float* xrow = (m < TP) ? a.in[0] + (size_t)m * 1024 : a.in[1] + (size_t)(m - TP) * 1024;
        x_row_prep(xrow, (bf16*)(ws + WS_XB) + (size_t)m * 1024, (float*)(ws + WS_SSQ) + (size_t)m * 16, lane);
        if (m >= TP) { const f32x4* xr = (const f32x4*)xrow + lane; f32x4* xo = (f32x4*)(a.out + O_Y + (size_t)m * 1024) + lane;
#pragma unroll
            for (int j = 0; j < 4; ++j) xo[64 * j] = xr[64 * j]; }
    }
}
DI void final_norm(const Args& a, int gw, int ngw, int lane) {
    const float* ssq = (const float*)(a.ws + WS_SSQ); const f32x4* g4 = (const f32x4*)a.in[8] + lane;
    for (int m = gw; m < T; m += ngw) {
        const float rs = pg8::row_rstd(ssq, m); f32x4* xr = (f32x4*)(a.out + (size_t)m * 1024) + lane;
#pragma unroll
        for (int j = 0; j < 4; ++j) { const f32x4 v = xr[64 * j], g = g4[64 * j]; xr[64 * j] = v * rs * g; }
    }
}

DI void pool_item(const Args& a, ldsp lds, int item, int tid) {
    const bool samp = item >= 2048; int b, ck, g;
    if (!samp) { b = item >> 8; ck = (item >> 2) & 63; g = item & 3; } else { const int r = item - 2048; b = r >> 2; g = r & 3; ck = 0; }
    const size_t tok0 = samp ? (size_t)TP + b * 64 : (size_t)b * 4096 + ck * 64;
    const int t0 = samp ? 0 : ck * 64;
    LAS float* U = (LAS float*)lds;
    LAS float* Dd = U + 79 * 96;
    LAS float* Wp = Dd + 64 * 97;
    const bf16* E0 = (const bf16*)(a.ws + WS_E);
    const float* cpool = a.in[2];
    {   u32x4 w[2]; f32x4 c0[2], c1[2]; int kind[2];
#pragma unroll
        for (int k = 0; k < 2; ++k) { const int idx = tid + NTHR * k, i = idx / 12, ch = idx % 12, tt = t0 - 15 + i;
            kind[k] = (idx >= 79 * 12) ? 3 : (tt >= 0) ? 0 : (samp ? 1 : 2);
            if (kind[k] == 0) w[k] = *(const u32x4*)(E0 + (tok0 + i - 15) * E0W + g * 96 + ch * 8);
            else if (kind[k] == 1) { const float* cp = cpool + (size_t)(b * 15 + i) * 384 + g * 96 + ch * 8; c0[k] = *(const f32x4*)cp; c1[k] = *(const f32x4*)(cp + 4); } }
#pragma unroll
        for (int k = 0; k < 2; ++k) { const int idx = tid + NTHR * k, i = idx / 12, ch = idx % 12;
            if (kind[k] == 3) continue;
            f32x4 a0 = {0.f, 0.f, 0.f, 0.f}, a1 = {0.f, 0.f, 0.f, 0.f};
            if (kind[k] == 0) { a0 = (f32x4){bflo(w[k].x), bfhi(w[k].x), bflo(w[k].y), bfhi(w[k].y)}; a1 = (f32x4){bflo(w[k].z), bfhi(w[k].z), bflo(w[k].w), bfhi(w[k].w)}; }
            else if (kind[k] == 1) { a0 = c0[k]; a1 = c1[k]; }
            LAS float* up = U + i * 96 + ch * 8; *(LAS f32x4*)up = a0; *(LAS f32x4*)(up + 4) = a1; } }
    for (int idx = tid; idx < 96 * 96; idx += NTHR) Wp[idx] = a.in[14][g * 9216 + idx];
    __syncthreads();
    if (samp || ck == 63) { float* po = a.out + (samp ? O_POOLS : O_POOLP);
        for (int idx = tid; idx < 15 * 96; idx += NTHR) { const int i = idx / 96, c = idx % 96; po[(size_t)(b * 15 + i) * 384 + g * 96 + c] = U[(64 + i) * 96 + c]; } }
    const int w = 2 << g;
    for (int idx = tid; idx < 64 * 96; idx += NTHR) { const int t = idx / 96, c = idx % 96; float s = 0.f;
        for (int j = 0; j < w; ++j) s += U[(15 + t - j) * 96 + c];
        const int pos = (samp ? 4096 : t0) + t; const int cnt = (pos + 1 < w) ? pos + 1 : w;
        Dd[t * 97 + c] = s / (float)cnt - U[(15 + t) * 96 + c]; }
    __syncthreads();
    { const int t = tid >> 3, d0 = (tid & 7) * 12; float acc[12];
#pragma unroll
      for (int i = 0; i < 12; ++i) acc[i] = 0.f;
      for (int c = 0; c < 96; ++c) { const float dv = Dd[t * 97 + c]; const LAS f32x4* wp = (const LAS f32x4*)(Wp + c * 96 + d0);
#pragma unroll
          for (int q = 0; q < 3; ++q) { const f32x4 wv = wp[q];
#pragma unroll
              for (int i = 0; i < 4; ++i) acc[4 * q + i] += dv * wv[i]; } }
      const float* sc = a.in[15] + g * 96 + d0;
      bf16* mo = (bf16*)(a.ws + WS_MIX) + (tok0 + t) * MIX0W + g * 96 + d0;
#pragma unroll
      for (int q = 0; q < 3; ++q) { u32x2 wv; wv.x = pk2(acc[4 * q] * sc[4 * q], acc[4 * q + 1] * sc[4 * q + 1]); wv.y = pk2(acc[4 * q + 2] * sc[4 * q + 2], acc[4 * q + 3] * sc[4 * q + 3]); *(u32x2*)(mo + 4 * q) = wv; } }
    __syncthreads();
}

constexpr int SWA_VS = 192;
DI void swa_unit(const Args& a, ldsp lds, int unit, int tid) {
    const int lane = tid & 63, wave = tid >> 6, r32 = lane & 31, hi = lane >> 5;
    const bool samp = unit >= 1024; int b, c, kvh;
    if (!samp) { b = unit >> 7; c = (unit >> 1) & 63; kvh = unit & 1; } else { const int r = unit - 1024; b = r >> 1; kvh = r & 1; c = 0; }
    const size_t tok0 = samp ? (size_t)TP + b * 64 : (size_t)b * 4096 + c * 64;
    const bf16* E0 = (const bf16*)(a.ws + WS_E);
    ldsp Kb = lds, Vb = lds + 3 * 8192;
    const bool last = samp || c == 63;
    {   const int key = tid >> 3, ch = tid & 7;
#pragma unroll
        for (int j = 0; j < 3; ++j) {
            u32x4 kw, vw; f32x4 kf0, kf1, vf0, vf1; bool valid = true;
            if (samp && j < 2) { const size_t off = ((size_t)(b * 128 + 64 * j + key) * 2 + kvh) * 64 + ch * 8;
                kf0 = *(const f32x4*)(a.in[3] + off); kf1 = *(const f32x4*)(a.in[3] + off + 4); vf0 = *(const f32x4*)(a.in[4] + off); vf1 = *(const f32x4*)(a.in[4] + off + 4);
                kw = pack8(kf0, kf1); vw = pack8(vf0, vf1);
            } else { const int kc = samp ? 0 : c - 2 + j; valid = kc >= 0;
                if (valid) { const size_t row = samp ? tok0 + key : (size_t)b * 4096 + kc * 64 + key;
                    kw = *(const u32x4*)(E0 + row * E0W + 1408 + kvh * 64 + ch * 8); vw = *(const u32x4*)(E0 + row * E0W + 1536 + kvh * 64 + ch * 8);
                    kf0 = (f32x4){bflo(kw.x), bfhi(kw.x), bflo(kw.y), bfhi(kw.y)}; kf1 = (f32x4){bflo(kw.z), bfhi(kw.z), bflo(kw.w), bfhi(kw.w)};
                    vf0 = (f32x4){bflo(vw.x), bfhi(vw.x), bflo(vw.y), bfhi(vw.y)}; vf1 = (f32x4){bflo(vw.z), bfhi(vw.z), bflo(vw.w), bfhi(vw.w)}; } }
            if (valid) {
                *(LAS u32x4*)(Kb + j * 8192 + ch * 1024 + ((key ^ ch) * 16)) = kw; *(LAS u32x4*)(Vb + j * (64 * SWA_VS) + key * SWA_VS + ch * 16) = vw;
                if (last && j >= 1) { const size_t oo = ((size_t)(b * 128 + (j - 1) * 64 + key) * 2 + kvh) * 64 + ch * 8;
                    float* ko = a.out + (samp ? O_SKS : O_SKP) + oo; float* vo = a.out + (samp ? O_SVS : O_SVP) + oo;
                    *(f32x4*)ko = kf0; *(f32x4*)(ko + 4) = kf1; *(f32x4*)vo = vf0; *(f32x4*)(vo + 4) = vf1; } }
        }
    }
    __syncthreads();
    {   const int head = kvh * 8 + wave; const float sink2 = a.in[16][head] * LOG2E;
        const int j0 = samp ? 0 : (c >= 2 ? 0 : 2 - c);
        const int i16 = lane & 15;
        const int vlo = (4 * hi + (i16 >> 2)) * SWA_VS + ((lane >> 4) & 1) * 32 + (i16 & 3) * 8;
        bf16* MO = (bf16*)(a.ws + WS_MIX);
#pragma unroll 1
        for (int rb = 0; rb < 2; ++rb) {
            const size_t qrow = tok0 + rb * 32 + r32; bf16x8 q[4];
#pragma unroll
            for (int d0 = 0; d0 < 4; ++d0) q[d0] = scale_q(*(const bf16x8*)(E0 + qrow * E0W + 384 + head * 64 + d0 * 16 + hi * 8));
            float m = sink2, l = hi ? 0.f : 1.f; f32x16 o[2]; o[0] = zero16(); o[1] = zero16(); f32x16 negm;
#pragma unroll
            for (int r = 0; r < 16; ++r) negm[r] = -sink2;
            for (int j = j0; j < 3; ++j) attn_tile<2, SWA_VS>(m, negm, l, o, Kb + j * 8192, 0, Vb + j * (64 * SWA_VS) + vlo, q, r32, hi, false);
            l += __shfl_xor(l, 32); const float inv = 1.0f / l;
#pragma unroll
            for (int db = 0; db < 2; ++db)
#pragma unroll
                for (int g = 0; g < 4; ++g) { u32x2 wv; wv.x = pk2(o[db][4 * g] * inv, o[db][4 * g + 1] * inv); wv.y = pk2(o[db][4 * g + 2] * inv, o[db][4 * g + 3] * inv);
                    *(u32x2*)(MO + qrow * MIX0W + 384 + head * 64 + 32 * db + 8 * g + 4 * hi) = wv; }
        }
    }
    __syncthreads();
}
constexpr int DF_VS = 320;
constexpr int DF_BUF = 16384 + 64 * DF_VS;
DI void diff_load(u32x4 (&kr)[2], u32x4 (&vr)[2], const Args& a, bool from_cache, size_t rowE, size_t rowC, int h, int tid) {
    const bf16* E1 = (const bf16*)(a.ws + WS_E);
#pragma unroll
    for (int i = 0; i < 2; ++i) { const int idx = tid + NTHR * i, key = idx >> 4, ch = idx & 15;
        if (!from_cache) { const bf16* p = E1 + (rowE + key) * E1W + h * 128 + ch * 8; kr[i] = *(const u32x4*)(p + 1024); vr[i] = *(const u32x4*)(p + 2048); }
        else { const size_t off = ((rowC + key) * 8 + h) * 128 + ch * 8; const float* kp = a.in[5] + off; const float* vp = a.in[6] + off;
            kr[i] = pack8(*(const f32x4*)kp, *(const f32x4*)(kp + 4)); vr[i] = pack8(*(const f32x4*)vp, *(const f32x4*)(vp + 4)); } }
}
DI void diff_store(ldsp buf, const u32x4 (&kr)[2], const u32x4 (&vr)[2], int tid) {
#pragma unroll
    for (int i = 0; i < 2; ++i) { const int idx = tid + NTHR * i, key = idx >> 4, ch = idx & 15;
        *(LAS u32x4*)(buf + ch * 1024 + ((key ^ ch) * 16)) = kr[i]; *(LAS u32x4*)(buf + 16384 + key * DF_VS + ch * 16) = vr[i]; }
}
template <bool SAMP> DI void diff_unit(const Args& a, ldsp lds, int b, int h, int qb, float lam, int tid) {
    constexpr bool samp = SAMP;
    const int lane = tid & 63, wave = tid >> 6, r32 = lane & 31, hi = lane >> 5, map = wave & 1, qblk = wave >> 1;
    const bf16* E1 = (const bf16*)(a.ws + WS_E);
    const size_t tok0 = samp ? (size_t)TP + b * 64 : (size_t)b * 4096 + 128 * qb;
    const int NT = samp ? 65 : 2 * qb + 2;
    const bool active = samp ? (wave < 4) : true;
    const int tmax = samp ? 64 : 2 * qb + (wave >> 2);
    const size_t qrow = tok0 + (active ? 32 * qblk : 0) + r32;
    bf16x8 q[4];
#pragma unroll
    for (int d0 = 0; d0 < 4; ++d0) q[d0] = scale_q(*(const bf16x8*)(E1 + qrow * E1W + h * 128 + map * 64 + d0 * 16 + hi * 8));
    float m = 0.f, l = 0.f; f32x16 o[4]; f32x16 negm = zero16();
#pragma unroll
    for (int i = 0; i < 4; ++i) o[i] = zero16();
    const int i16 = lane & 15;
    const int vlo = 16384 + (4 * hi + (i16 >> 2)) * DF_VS + ((lane >> 4) & 1) * 32 + (i16 & 3) * 8;
    if constexpr (!SAMP) {
    u32x4 krA[2], vrA[2], krB[2], vrB[2];
    const size_t seq0 = (size_t)b * 4096;
#define DLOAD(KR, VR, tt) diff_load(KR, VR, a, samp && ((tt) < 64), samp ? tok0 : seq0 + 64 * (size_t)(tt), seq0 + 64 * (size_t)(tt), h, tid)
    DLOAD(krA, vrA, 0);
    diff_store(lds, krA, vrA, tid);
    if (1 < NT) DLOAD(krA, vrA, 1);
    __syncthreads();
    int curoff = 0;
#define DSTEP(tt, LKR, LVR, SKR, SVR) do { \
        const int nxtoff = (curoff == 2 * DF_BUF) ? 0 : curoff + DF_BUF; \
        if ((tt) + 2 < NT) DLOAD(LKR, LVR, (tt) + 2); \
        if (active && (tt) <= tmax) attn_tile<4, DF_VS>(m, negm, l, o, lds + curoff, 8 * map, lds + curoff + vlo, q, r32, hi, (tt) == 0); \
        if ((tt) + 1 < NT) diff_store(lds + nxtoff, SKR, SVR, tid); \
        asm volatile("s_waitcnt lgkmcnt(0)\n\ts_barrier" ::: "memory");     \
        curoff = nxtoff; } while (0)
#pragma unroll 1
    for (int t = 0; t < NT; t += 2) {
        DSTEP(t, krB, vrB, krA, vrA);
        if (t + 1 >= NT) break;
        DSTEP(t + 1, krA, vrA, krB, vrB);
    }
#undef DSTEP
    __syncthreads();
#undef DLOAD
    } else {
    u32x4 kr[2], vr[2];
    const size_t seq0 = (size_t)b * 4096;
    diff_load(kr, vr, a, samp, samp ? tok0 : seq0, seq0, h, tid);
    diff_store(lds, kr, vr, tid);
    __syncthreads();
#pragma unroll 1
    for (int t = 0; t < NT; ++t) {
        cldsp cur = lds + (t & 1) * DF_BUF;
        if (t + 1 < NT) diff_load(kr, vr, a, samp && (t + 1 < 64), samp ? tok0 : seq0 + 64 * (t + 1), seq0 + 64 * (t + 1), h, tid);
        if (active && t <= tmax) attn_tile<4, DF_VS>(m, negm, l, o, cur, 8 * map, cur + vlo, q, r32, hi, t == 0);
        if (t + 1 < NT) diff_store(lds + ((t + 1) & 1) * DF_BUF, kr, vr, tid);
        __syncthreads();
    }
    }
    l += __shfl_xor(l, 32);
    LAS float* xch = (LAS float*)lds + qblk * 4096 + lane;
    if (active && map == 1) { const float sc = lam / l;
#pragma unroll
        for (int db = 0; db < 4; ++db)
#pragma unroll
            for (int r = 0; r < 16; ++r) xch[(db * 16 + r) * 64] = o[db][r] * sc; }
    __syncthreads();
    if (active && map == 0) {
        const float i1 = 1.0f / l; float ss = 0.f;
#pragma unroll
        for (int db = 0; db < 4; ++db)
#pragma unroll
            for (int r = 0; r < 16; ++r) { const float v = o[db][r] * i1 - xch[(db * 16 + r) * 64]; o[db][r] = v; ss += v * v; }
        ss += __shfl_xor(ss, 32);
        const float lam_init = 0.8f - 0.6f * 0.74081822068171786f;
        const float rn = (1.0f / sqrtf(ss * (1.0f / 128.0f) + 1e-6f)) * (1.0f - lam_init);
        bf16* MO = (bf16*)(a.ws + WS_MIX) + qrow * MIX1W + h * 128;
        const float* sg = a.in[20];
#pragma unroll
        for (int db = 0; db < 4; ++db)
#pragma unroll
            for (int g = 0; g < 4; ++g) { const int d = 32 * db + 8 * g + 4 * hi; const f32x4 gg = *(const f32x4*)(sg + d);
                u32x2 wv; wv.x = pk2(o[db][4 * g] * rn * gg[0], o[db][4 * g + 1] * rn * gg[1]); wv.y = pk2(o[db][4 * g + 2] * rn * gg[2], o[db][4 * g + 3] * rn * gg[3]);
                *(u32x2*)(MO + d) = wv; }
    }
    __syncthreads();
}

DI void gmlp_item(const Args& a, ldsp lds, int item, int tid) {
    const int lane = tid & 63, wave = tid >> 6;
    const int ci = item >> 2, g = item & 3; const bool samp = ci >= 256;
    const int b = samp ? ci - 256 : ci >> 5; const int LC = samp ? 64 : 128;
    const size_t tok0 = samp ? (size_t)TP + b * 64 : (size_t)b * 4096 + (ci & 31) * 128;
    const bf16* E1 = (const bf16*)(a.ws + WS_E);
    LAS float* Wl = (LAS float*)lds;
    LAS float* VG = Wl + 128 * 132;
    const float* Wg = a.in[23] + (size_t)g * 128 * 128;
    {   f32x4 wr8[8];
#pragma unroll
        for (int k = 0; k < 8; ++k) { const int idx = tid + NTHR * k; wr8[k] = (f32x4){0.f, 0.f, 0.f, 0.f}; if (idx < LC * 32) wr8[k] = *((const f32x4*)Wg + idx); }
#pragma unroll
        for (int k = 0; k < 8; ++k) { const int idx = tid + NTHR * k, t = idx >> 5, s4 = (idx & 31) * 4;
            if (idx < LC * 32) { f32x4 v = wr8[k]; v[0] = (s4 <= t) ? v[0] : 0.f; v[1] = (s4 + 1 <= t) ? v[1] : 0.f; v[2] = (s4 + 2 <= t) ? v[2] : 0.f; v[3] = (s4 + 3 <= t) ? v[3] : 0.f;
                *(LAS f32x4*)(Wl + t * 132 + s4) = v; } } }
    for (int rb = 0; rb < LC / NWAVES; rb += 8) {
        u32x4 wv8[8];
#pragma unroll
        for (int k = 0; k < 8; ++k) { const int row = wave + NWAVES * (rb + k); wv8[k] = (u32x4){0u, 0u, 0u, 0u};
            if (lane < 48) wv8[k] = *(const u32x4*)(E1 + (tok0 + row) * E1W + 3456 + lane * 8); }
#pragma unroll
        for (int k = 0; k < 8; ++k) { const int row = wave + NWAVES * (rb + k); const u32x4 w = wv8[k];
            float x[8]; float s = 0.f;
            x[0] = bflo(w.x); x[1] = bfhi(w.x); x[2] = bflo(w.y); x[3] = bfhi(w.y); x[4] = bflo(w.z); x[5] = bfhi(w.z); x[6] = bflo(w.w); x[7] = bfhi(w.w);
#pragma unroll
            for (int i = 0; i < 8; ++i) { x[i] = (lane < 48) ? gelu_erf(x[i]) : 0.f; s += x[i]; }
            const float mean = wave_sum(s) * (1.0f / 384.0f); float q = 0.f;
#pragma unroll
            for (int i = 0; i < 8; ++i) { x[i] = (lane < 48) ? x[i] - mean : 0.f; q += x[i] * x[i]; }
            const float rstd = 1.0f / sqrtf(wave_sum(q) * (1.0f / 384.0f) + 1e-6f);
            if (lane >= 12 * g && lane < 12 * g + 12) {
                const float* lg = a.in[21] + lane * 8; const float* lb = a.in[22] + lane * 8;
                float y[8];
#pragma unroll
                for (int i = 0; i < 8; ++i) y[i] = x[i] * rstd * lg[i] + lb[i];
                LAS float* vo = VG + row * 96 + (lane - 12 * g) * 8;
                *(LAS f32x4*)vo = (f32x4){y[0], y[1], y[2], y[3]}; *(LAS f32x4*)(vo + 4) = (f32x4){y[4], y[5], y[6], y[7]};
                if (samp) { float* go = a.out + O_GV + ((size_t)(b * 64 + row) * 384 + lane * 8); *(f32x4*)go = (f32x4){y[0], y[1], y[2], y[3]}; *(f32x4*)(go + 4) = (f32x4){y[4], y[5], y[6], y[7]}; }
            }
        }
    }
    __syncthreads();
    {   const int tq = tid >> 4, cq = tid & 15;
        if (tq * 4 < LC) {
            float acc[4][6];
#pragma unroll
            for (int i = 0; i < 4; ++i)
#pragma unroll
                for (int j = 0; j < 6; ++j) acc[i][j] = 0.f;
            for (int sc = 0; sc <= tq; ++sc) {
                f32x4 wv[4];
#pragma unroll
                for (int i = 0; i < 4; ++i) wv[i] = *(const LAS f32x4*)(Wl + (4 * tq + i) * 132 + 4 * sc);
#pragma unroll
                for (int k = 0; k < 4; ++k) { const LAS float* vp = VG + (4 * sc + k) * 96 + 6 * cq; float v[6];
#pragma unroll
                    for (int j = 0; j < 6; ++j) v[j] = vp[j];
#pragma unroll
                    for (int i = 0; i < 4; ++i)
#pragma unroll
                        for (int j = 0; j < 6; ++j) acc[i][j] += wv[i][k] * v[j]; }
            }
            bf16* MO = (bf16*)(a.ws + WS_MIX);
#pragma unroll
            for (int i = 0; i < 4; ++i) { const int t = 4 * tq + i; const float bias = a.in[24][g * 128 + t]; const size_t tok = tok0 + t;
                const unsigned* up = (const unsigned*)(E1 + tok * E1W + 3072 + g * 96 + 6 * cq); unsigned* op = (unsigned*)(MO + tok * MIX1W + 1024 + g * 96 + 6 * cq);
#pragma unroll
                for (int j = 0; j < 3; ++j) { const unsigned w = up[j]; op[j] = pk2(gelu_erf(bflo(w)) * (acc[i][2 * j] + bias), gelu_erf(bfhi(w)) * (acc[i][2 * j + 1] + bias)); } }
        }
    }
    __syncthreads();
}

#define XB_TMO      128
#define XB_XCNT(j)  (256  + 64 * (j))
#define XB_XSUB(j)  (1280 + 64 * (j))
#define XB_XGEN(j)  (2304 + 64 * (j))
#define XB_TOP      3328
#define XB_TOPGEN   3392
#define XCD_BAR_WORDS 3456
#define XB_SPIN_CAP (1u << 18)

__device__ __forceinline__ unsigned xb_ld(unsigned* p)              { return __hip_atomic_load(p, __ATOMIC_RELAXED, __HIP_MEMORY_SCOPE_AGENT); }
__device__ __forceinline__ unsigned xb_add(unsigned* p, unsigned v) { return __hip_atomic_fetch_add(p, v, __ATOMIC_RELAXED, __HIP_MEMORY_SCOPE_AGENT); }
__device__ __forceinline__ unsigned xb_xcc_id() { return (unsigned)__builtin_amdgcn_s_getreg((3 << 11) | 20) & 0xFu; }
#define XB_SPIN(cond, bar) do { unsigned _sp = 0; while (cond) { __builtin_amdgcn_s_sleep(1); \
    if ((++_sp & 255u) == 0u) { if (xb_ld(&(bar)[XB_TMO])) break; if (_sp > XB_SPIN_CAP) { atomicAdd(&(bar)[XB_TMO], 1u); break; } } } } while (0)

struct XcdBarrier {
    unsigned* bar; unsigned x;
    volatile LAS unsigned* st;
};

__device__ __forceinline__ XcdBarrier xcd_barrier_post(unsigned* bar, volatile LAS unsigned* st) {
    XcdBarrier b; b.bar = bar; b.x = xb_xcc_id(); b.st = st;
    if (threadIdx.x == 0) (void)xb_add(&bar[XB_XCNT(b.x)], 1u);
    return b;
}
__device__ __forceinline__ void xcd_barrier_complete(unsigned* bar, unsigned x, unsigned& nloc, unsigned& nx) {
    const unsigned G = gridDim.x * gridDim.y * gridDim.z;
    unsigned sum, cnt, mine, sp = 0u;
    for (;;) {
        sum = 0u; cnt = 0u; mine = 0u;
#pragma unroll
        for (unsigned j = 0; j < 16; ++j) { const unsigned c = xb_ld(&bar[XB_XCNT(j)]); sum += c; cnt += (c > 0u) ? 1u : 0u; mine = (j == x) ? c : mine; }
        if (sum == G) break;
        __builtin_amdgcn_s_sleep(1);
        if ((++sp & 255u) == 0u) { if (xb_ld(&bar[XB_TMO])) break; if (sp > XB_SPIN_CAP) { atomicAdd(&bar[XB_TMO], 1u); break; } }
    }
    nloc = mine > 0u ? mine : 1u; nx = cnt > 0u ? cnt : 1u;
}

__device__ __forceinline__ void xcd_barrier(const XcdBarrier& b) {
    asm volatile("s_waitcnt vmcnt(0)" ::: "memory");
    __syncthreads();
    if (threadIdx.x == 0) {
        unsigned* bar = b.bar;
        __builtin_amdgcn_s_waitcnt(0);
        unsigned nloc = b.st[0], nx = b.st[1];
        if (nloc == 0u) { xcd_barrier_complete(bar, b.x, nloc, nx); b.st[0] = nloc; b.st[1] = nx; }
        const unsigned old = xb_add(&bar[XB_XSUB(b.x)], 1u);
        const unsigned gen = old / nloc;
        if (old + 1u == (gen + 1u) * nloc) {
            __builtin_amdgcn_fence(__ATOMIC_RELEASE, "agent");
            asm volatile("s_waitcnt vmcnt(0)" ::: "memory");
            const unsigned og = xb_add(&bar[XB_TOP], 1u);
            const unsigned tg = og / nx;
            if (og + 1u == (tg + 1u) * nx) xb_add(&bar[XB_TOPGEN], 1u);
            else XB_SPIN(xb_ld(&bar[XB_TOPGEN]) == tg, bar);
            __builtin_amdgcn_fence(__ATOMIC_ACQUIRE, "agent");
            xb_add(&bar[XB_XGEN(b.x)], 1u);
            asm volatile("s_waitcnt vmcnt(0)" ::: "memory");
        } else {
            XB_SPIN(xb_ld(&bar[XB_XGEN(b.x)]) == gen, bar);
            __builtin_amdgcn_fence(__ATOMIC_ACQUIRE, "agent");
            asm volatile("s_waitcnt vmcnt(0)" ::: "memory");
        }
    }
    __syncthreads();
}

constexpr int GM_RS = 272;
constexpr int GV_RS = 832;
DI void gmlp_chunk(const Args& a, ldsp lds, int ci, int tid) {
    const int lane = tid & 63, wave = tid >> 6, r32 = lane & 31, hi = lane >> 5;
    const bool samp = ci >= 256; const int b = samp ? ci - 256 : ci >> 5; const int LC = samp ? 64 : 128;
    const size_t tok0 = samp ? (size_t)TP + b * 64 : (size_t)b * 4096 + (ci & 31) * 128;
    const bf16* E1 = (const bf16*)(a.ws + WS_E);
    ldsp VG = lds;
    ldsp Wl = lds + 128 * GV_RS;
    for (int rb = 0; rb < LC / NWAVES; rb += 8) {
        u32x4 wv8[8];
#pragma unroll
        for (int k = 0; k < 8; ++k) { const int row = wave + NWAVES * (rb + k); wv8[k] = (u32x4){0u, 0u, 0u, 0u};
            if (lane < 48) wv8[k] = *(const u32x4*)(E1 + (tok0 + row) * E1W + 3456 + lane * 8); }
#pragma unroll
        for (int k = 0; k < 8; ++k) { const int row = wave + NWAVES * (rb + k); const u32x4 w = wv8[k];
            float x[8]; float s = 0.f;
            x[0] = bflo(w.x); x[1] = bfhi(w.x); x[2] = bflo(w.y); x[3] = bfhi(w.y); x[4] = bflo(w.z); x[5] = bfhi(w.z); x[6] = bflo(w.w); x[7] = bfhi(w.w);
#pragma unroll
            for (int i = 0; i < 8; ++i) { x[i] = (lane < 48) ? gelu_erf(x[i]) : 0.f; s += x[i]; }
            const float mean = wave_sum(s) * (1.0f / 384.0f); float q = 0.f;
#pragma unroll
            for (int i = 0; i < 8; ++i) { x[i] = (lane < 48) ? x[i] - mean : 0.f; q += x[i] * x[i]; }
            const float rstd = 1.0f / sqrtf(wave_sum(q) * (1.0f / 384.0f) + 1e-6f);
            if (lane < 48) {
                const float* lg = a.in[21] + lane * 8; const float* lb = a.in[22] + lane * 8;
                float y[8];
#pragma unroll
                for (int i = 0; i < 8; ++i) y[i] = x[i] * rstd * lg[i] + lb[i];
                *(LAS u32x4*)(VG + row * GV_RS + lane * 16) = pack8((f32x4){y[0], y[1], y[2], y[3]}, (f32x4){y[4], y[5], y[6], y[7]});
                if (samp) { float* go = a.out + O_GV + ((size_t)(b * 64 + row) * 384 + lane * 8); *(f32x4*)go = (f32x4){y[0], y[1], y[2], y[3]}; *(f32x4*)(go + 4) = (f32x4){y[4], y[5], y[6], y[7]}; }
            }
        }
    }
    bf16* MO = (bf16*)(a.ws + WS_MIX);
#pragma unroll 1
    for (int g = 0; g < 4; ++g) {
        {   const float* Wg = a.in[23] + (size_t)g * 128 * 128; f32x4 wr8[8];
#pragma unroll
            for (int k = 0; k < 8; ++k) { const int idx = tid + NTHR * k; wr8[k] = (f32x4){0.f, 0.f, 0.f, 0.f}; if (idx < LC * 32) wr8[k] = *((const f32x4*)Wg + idx); }
#pragma unroll
            for (int k = 0; k < 8; ++k) { const int idx = tid + NTHR * k, t = idx >> 5, s4 = (idx & 31) * 4;
                if (idx < LC * 32) { const f32x4 v = wr8[k]; u32x2 pw;
                    pw.x = pk2((s4 <= t) ? v[0] : 0.f, (s4 + 1 <= t) ? v[1] : 0.f); pw.y = pk2((s4 + 2 <= t) ? v[2] : 0.f, (s4 + 3 <= t) ? v[3] : 0.f);
                    *(LAS u32x2*)(Wl + t * GM_RS + s4 * 2) = pw; } } }
        __syncthreads();
        if (wave < 6) {
            const int cb = wave % 3;
#pragma unroll 1
            for (int pass = 0; pass < 2; ++pass) {
                const int tb = (wave < 3) ? (pass ? 0 : 3) : (pass ? 1 : 2);
                if (tb * 32 < LC) {
                    f32x16 acc = zero16();
                    const int i16 = lane & 15;
                    cldsp ap = Wl + (32 * tb + r32) * GM_RS + 8 * hi;
                    cldsp bp = VG + (4 * hi + (i16 >> 2)) * GV_RS + (96 * g + 32 * cb) * 2 + ((lane >> 4) & 1) * 32 + (i16 & 3) * 8;
                    for (int ks = 0; ks < 2 * tb + 2; ++ks) {
                        const v4i16_t alo = *(const LAS v4i16_t*)(ap + 32 * ks), ahi = *(const LAS v4i16_t*)(ap + 32 * ks + 16);
                        const v4i16_t blo = vtr(bp + (16 * ks) * GV_RS), bhi = vtr(bp + (16 * ks + 8) * GV_RS);
                        acc = MFMA32(__builtin_shufflevector(alo, ahi, 0, 1, 2, 3, 4, 5, 6, 7), __builtin_shufflevector(blo, bhi, 0, 1, 2, 3, 4, 5, 6, 7), acc);
                    }
                    const int col = g * 96 + 32 * cb + r32;
#pragma unroll
                    for (int r = 0; r < 16; ++r) { const int t = 32 * tb + (r & 3) + 8 * (r >> 2) + 4 * hi; const size_t tok = tok0 + t;
                        const float u = bf2f(E1[tok * E1W + 3072 + col]);
                        MO[tok * MIX1W + 1024 + col] = (bf16)f2bf(gelu_erf(u) * (acc[r] + a.in[24][g * 128 + t])); }
                }
            }
        }
        __syncthreads();
    }
}

template <class Epi> DI void run_gemm(ldsp lds, const bf16* A, const bf16* Bt, int N, int K, const Epi& E, int M = T) {
    pg8::Gemm g{A, Bt, M, N, K, K}; pg8::StaticOrder S; S.init(M, N, (int)gridDim.x, (int)blockIdx.x);
    pg8::gemm_phase<Epi, pg8::StaticOrder, true, true>(lds, g, S, E);
}
DI void run_res_gemm(const XcdBarrier& xbar, ldsp lds, const bf16* A, const bf16* Bt, int K, const float* base, float* X, bf16* XB, float* SSQ, float* P, float alpha, int ngw) {
    { pg8::EpiRes E{base, X, XB, SSQ, alpha}; run_gemm(lds, A, Bt, 1024, K, E, TP); }
    { int ksub = K / 11; asm volatile("" : "+s"(ksub));
      pg8::Gemm g{A, Bt, T, 1024, ksub, K}; pg8::TailOrder S; S.init(ksub, (int)gridDim.x, (int)blockIdx.x); pg8::EpiPart E{P, alpha, ksub * 2};
      pg8::gemm_phase<pg8::EpiPart, pg8::TailOrder, true, true>(lds, g, S, E); }
    xcd_barrier(xbar);
    { const int t2 = fresh_tid(), lane2 = t2 & 63, gw2 = (int)blockIdx.x * NWAVES + __builtin_amdgcn_readfirstlane(t2 >> 6);
      for (int it = gw2; it < 4 * TS; it += ngw) { const int m = TP + (it >> 2); tail_reduce_quarter(X + (size_t)m * 1024, P + (size_t)(m - TP) * 1024, XB + (size_t)m * 1024, SSQ + (size_t)m * 16, it & 3, lane2); } }
}
__global__ void __launch_bounds__(NTHR, 2) fwd_mega(Args args) {
    extern __shared__ __attribute__((aligned(16))) unsigned char lds_raw[];
    ldsp lds = (ldsp)lds_raw;
    cg::grid_group grid = cg::this_grid();
    for (int u = threadIdx.x; u < (LDS_BYTES - LDSCTL_OFF) / 4; u += NTHR) ((LAS unsigned*)(lds + LDSCTL_OFF))[u] = 0u;
    __syncthreads();
    const XcdBarrier xbar = xcd_barrier_post((unsigned*)args.ws + 4096, (volatile LAS unsigned*)(lds + LDSCTL_OFF + 352));
    const int G = gridDim.x, bid = blockIdx.x, ngw = G * NWAVES;
    const int lo = args.ph_lo, hi = args.ph_hi;
    unsigned char* ws = args.ws;
    bf16* XB = (bf16*)(ws + WS_XB); bf16* HB = (bf16*)(ws + WS_H); bf16* EB = (bf16*)(ws + WS_E); bf16* MB = (bf16*)(ws + WS_MIX);
    float* SSQ = (float*)(ws + WS_SSQ); float* X = args.out + O_Y; float* PART = (float*)(ws + WS_PART);
#define IN(k) (lo <= (k) && (k) < hi)
#define SEAM(k) do { if (IN(k) && IN((k) + 1)) { if ((k) == 0 && hi > 1000) grid.sync(); else xcd_barrier(xbar); } } while (0)
    #ifndef DBG_NO_P0
    if (IN(0)) { const int t2 = fresh_tid(), w2 = __builtin_amdgcn_readfirstlane(t2 >> 6); p0_prologue(args, lds, (int)blockIdx.x * NWAVES + w2, ngw, w2, t2 & 63); }
#endif
    SEAM(0);
#define FFN_PHASES(pg, mat, first) \
    if (IN(pg)) { pg8::EpiGU E{HB, SSQ}; run_gemm(lds, XB, (const bf16*)(ws + WS_WGU) + (size_t)(mat) * WGU_STRIDE, 5632, 1024, E); } SEAM(pg); \
    if (IN((pg) + 1)) { run_res_gemm(xbar, lds, HB, (const bf16*)(ws + WS_WD) + (size_t)(mat) * WD_STRIDE, 2816, (first) ? args.in[0] : X, X, XB, SSQ, PART, 0.5f, ngw); } SEAM((pg) + 1);
    FFN_PHASES(1, 0, true)
    if (IN(3)) { pg8::EpiIn E{EB, E0W, SSQ, nullptr, nullptr}; run_gemm(lds, XB, (const bf16*)(ws + WS_WEI), 1792, 1024, E); } SEAM(3);
    if (IN(4)) {
#ifndef DBG_NO_SWA
        if (G == 256) { const int v = (bid & 7) * 32 + (bid >> 3);
            for (int k = 0; k < 4; ++k) swa_unit(args, lds, 4 * v + k, fresh_tid());
            if (v < 32) swa_unit(args, lds, 1024 + v, fresh_tid());
        } else { for (int u = bid; u < 1056; u += G) swa_unit(args, lds, u, fresh_tid()); }
#endif
#ifndef DBG_NO_POOL
        for (int it = bid; it < 2112; it += G) pool_item(args, lds, it, fresh_tid());
#endif
    }
#if DBG_REP4 > 1
    grid.sync();
    if (IN(4)) {
#ifndef DBG_NO_SWA
        if (G == 256) { const int v = (bid & 7) * 32 + (bid >> 3);
            for (int k = 0; k < 4; ++k) swa_unit(args, lds, 4 * v + k, fresh_tid());
            if (v < 32) swa_unit(args, lds, 1024 + v, fresh_tid());
        } else { for (int u = bid; u < 1056; u += G) swa_unit(args, lds, u, fresh_tid()); }
#endif
#ifndef DBG_NO_POOL
        for (int it = bid; it < 2112; it += G) pool_item(args, lds, it, fresh_tid());
#endif
    }
#endif
    SEAM(4);
    if (IN(5)) { run_res_gemm(xbar, lds, MB, (const bf16*)(ws + WS_WEO), 1408, X, X, XB, SSQ, PART, 1.0f, ngw); } SEAM(5);
    FFN_PHASES(6, 1, false)
    FFN_PHASES(8, 2, false)
    if (IN(10)) { pg8::EpiIn E{EB, E1W, SSQ, args.out + O_DK, args.out + O_DV}; run_gemm(lds, XB, (const bf16*)(ws + WS_WOI), 3840, 1024, E); } SEAM(10);
    if (IN(11)) {
        const float* lp = args.in[19];
        const int lane = fresh_tid() & 63;
        const float lam = expf(wave_sum(lp[lane] * lp[64 + lane])) - expf(wave_sum(lp[128 + lane] * lp[192 + lane])) + (0.8f - 0.6f * 0.74081822068171786f);
#ifndef DBG_NO_DIFF
        for (int v0 = bid; v0 < 256; v0 += G) { const int v = (G == 256) ? (v0 & 7) * 32 + (v0 >> 3) : v0; const int bh = v >> 2, s = v & 3;
#pragma unroll 1
            for (int k = 0; k < 8; ++k) { const int qb = 8 * (k >> 1) + ((k & 1) ? 7 - s : s); diff_unit<false>(args, lds, bh >> 3, bh & 7, qb, lam, fresh_tid()); } }
        for (int u = bid; u < 128; u += G) diff_unit<true>(args, lds, u >> 3, u & 7, 0, lam, fresh_tid());
#endif
#ifndef DBG_NO_GMLP
        if (G == 256) {
            if (bid >= 128) { for (int ci = bid - 128; ci < 272; ci += 128) gmlp_chunk(args, lds, ci, fresh_tid()); }
        } else { for (int it = G - 1 - bid; it < 1088; it += G) gmlp_item(args, lds, it, fresh_tid()); }
#endif
    }
#if DBG_REP11 > 1
    grid.sync();
    if (IN(11)) {
        const float* lp = args.in[19];
        const int lane = fresh_tid() & 63;
        const float lam = expf(wave_sum(lp[lane] * lp[64 + lane])) - expf(wave_sum(lp[128 + lane] * lp[192 + lane])) + (0.8f - 0.6f * 0.74081822068171786f);
#ifndef DBG_NO_DIFF
        for (int v0 = bid; v0 < 256; v0 += G) { const int v = (G == 256) ? (v0 & 7) * 32 + (v0 >> 3) : v0; const int bh = v >> 2, s = v & 3;
#pragma unroll 1
            for (int k = 0; k < 8; ++k) { const int qb = 8 * (k >> 1) + ((k & 1) ? 7 - s : s); diff_unit<false>(args, lds, bh >> 3, bh & 7, qb, lam, fresh_tid()); } }
        for (int u = bid; u < 128; u += G) diff_unit<true>(args, lds, u >> 3, u & 7, 0, lam, fresh_tid());
#endif
#ifndef DBG_NO_GMLP
        if (G == 256) {
            if (bid >= 128) { for (int ci = bid - 128; ci < 272; ci += 128) gmlp_chunk(args, lds, ci, fresh_tid()); }
        } else { for (int it = G - 1 - bid; it < 1088; it += G) gmlp_item(args, lds, it, fresh_tid()); }
#endif
    }
#endif
    SEAM(11);
    if (IN(12)) { run_res_gemm(xbar, lds, MB, (const bf16*)(ws + WS_WOO), 1408, X, X, XB, SSQ, PART, 1.0f, ngw); } SEAM(12);
    FFN_PHASES(13, 3, false)
    if (IN(15)) { const int t2 = fresh_tid(); final_norm(args, (int)blockIdx.x * NWAVES + __builtin_amdgcn_readfirstlane(t2 >> 6), ngw, t2 & 63); }
#undef IN
#undef SEAM
}

#ifndef MK_PER_PHASE
#define MK_PER_PHASE 0
#endif
extern "C" void kernel_launch(void* const* d_in, const int* in_sizes, int n_in, void* d_out, int out_size, void* d_ws, size_t ws_size, hipStream_t stream) {
    static int grid = 0;
    if (grid == 0) {
        if (n_in != 25 || (size_t)out_size != O_END || ws_size < WS_END) { fprintf(stderr, "kernel_launch: unexpected shapes: n_in %d out %d ws %zu\n", n_in, out_size, ws_size); grid = -1; return; }
        int dev = 0, cus = 0, per_cu = 0;
        if (hipGetDevice(&dev) != hipSuccess || hipDeviceGetAttribute(&cus, hipDeviceAttributeMultiprocessorCount, dev) != hipSuccess) { grid = -1; return; }
        if (hipFuncSetAttribute((const void*)fwd_mega, hipFuncAttributeMaxDynamicSharedMemorySize, LDS_BYTES) != hipSuccess) { fprintf(stderr, "kernel_launch: hipFuncSetAttribute failed\n"); grid = -1; return; }
        if (hipOccupancyMaxActiveBlocksPerMultiprocessor(&per_cu, (const void*)fwd_mega, NTHR, LDS_BYTES) != hipSuccess || per_cu < 1) { fprintf(stderr, "kernel_launch: occupancy query says %d\n", per_cu); per_cu = 1; }
        (void)hipGetLastError();
        grid = cus * 1;
    }
    if (grid < 0) return;
    if (hipMemsetAsync(d_ws, 0, 65536, stream) != hipSuccess) { fprintf(stderr, "kernel_launch: hipMemsetAsync failed\n"); return; }
    Args a{};
    for (int i = 0; i < 25; ++i) a.in[i] = (const float*)d_in[i];
    a.out = (float*)d_out; a.ws = (unsigned char*)d_ws;
#if MK_PER_PHASE
#ifndef DBG_PH_HI
#define DBG_PH_HI 16
#endif
    for (int p = 0; p < DBG_PH_HI; ++p) { a.ph_lo = p; a.ph_hi = p + 1; hipLaunchKernelGGL(fwd_mega, dim3(grid), dim3(NTHR), LDS_BYTES, stream, a); }
#else
    a.ph_lo = 0; a.ph_hi = 16;
    void* kargs[] = {&a};
    hipError_t e = hipLaunchCooperativeKernel((const void*)fwd_mega, dim3(grid), dim3(NTHR), kargs, LDS_BYTES, stream);
    if (e != hipSuccess) fprintf(stderr, "kernel_launch: cooperative launch failed: %s (grid %d)\n", hipGetErrorString(e), grid);
#endif
}
```
